# Optimizing an MI355X kernel written in HIP

```python
import jax
import jax.numpy as jnp
from jax import lax
import numpy as np

D_MODEL = 1024
BATCH = 8
SEQ = 8192
DEPTH = 1

D_RNN = D_MODEL
N_LRU_BLOCKS = 16
LRU_BLOCK = D_RNN // N_LRU_BLOCKS
CONV_WIDTH = 4
LRU_C = 8.0
N_HEADS = 16
HEAD_DIM = 64
N_KV_GROUPS = 4
HEADS_PER_GROUP = N_HEADS // N_KV_GROUPS
D_ATTN = N_HEADS * HEAD_DIM
D_KV = N_KV_GROUPS * HEAD_DIM
CMP_LEN = 32
CMP_STRIDE = 16
CMP_HIDDEN = 256
SEL_LEN = 64
SEL_TOPK = 16
WINDOW = 512
Q_BLOCK = 64
FORCE_SCORE = 1e4
R_SEL = SEL_LEN // CMP_STRIDE
R_CMP = CMP_LEN // CMP_STRIDE
ALIBI_MAX_BIAS = 8.0
D_FF = 2816
D_PLE = 256
NORM_EPS = 1e-6

_IN_SIZES = (D_RNN, D_RNN, D_ATTN, D_KV, D_KV, D_KV, D_KV, D_KV, D_KV, 3 * N_HEADS, D_MODEL, D_MODEL)
D_IN = sum(_IN_SIZES)
IN_SPLITS = tuple(int(c) for c in np.cumsum(_IN_SIZES)[:-1])

kernel_name = "hybrid_rglru_nsa_sandwich_block"


def rmsnorm(x, g):
    x32 = x.astype(jnp.float32)
    y = x32 * lax.rsqrt(jnp.mean(x32 * x32, axis=-1, keepdims=True) + NORM_EPS)
    return (y * g.astype(jnp.float32)).astype(x.dtype)


def alibi_slopes():
    h = jnp.arange(1, N_HEADS + 1, dtype=jnp.float32)
    return jnp.exp2(-ALIBI_MAX_BIAS * h / N_HEADS)


def masked_softmax(s, mask):
    s = jnp.where(mask, s.astype(jnp.float32), -jnp.inf)
    m = jnp.max(s, axis=-1, keepdims=True)
    m = jnp.where(jnp.isfinite(m), m, 0.0)
    e = jnp.where(mask, jnp.exp(s - m), 0.0)
    return e / jnp.maximum(jnp.sum(e, axis=-1, keepdims=True), 1e-30)


def causal_conv(x, w, b):
    S = x.shape[1]
    xp = jnp.pad(x, ((0, 0), (CONV_WIDTH - 1, 0), (0, 0)))
    y = b
    for k in range(CONV_WIDTH):
        y = y + xp[:, k:k + S] * w[k]
    return y


def _lru_combine(c1, c2):
    a1, b1 = c1
    a2, b2 = c2
    return a1 * a2, a2 * b1 + b2


def rg_lru(xc, wa, ba, wx, bx, lam):
    B, S, _ = xc.shape
    xb = xc.reshape(B, S, N_LRU_BLOCKS, LRU_BLOCK)
    r = jax.nn.sigmoid(jnp.einsum('bsnd,nde->bsne', xb, wa).reshape(B, S, D_RNN) + ba)
    i = jax.nn.sigmoid(jnp.einsum('bsnd,nde->bsne', xb, wx).reshape(B, S, D_RNN) + bx)
    log_a = (-LRU_C * r.astype(jnp.float32)) * jax.nn.softplus(-lam.astype(jnp.float32))
    a = jnp.exp(log_a)
    b = jnp.sqrt(-jnp.expm1(2.0 * log_a)) * (i * xc).astype(jnp.float32)
    _, h = lax.associative_scan(_lru_combine, (a, b), axis=1)
    return h.astype(xc.dtype)


def compress(kv, pos, w1, w2):
    B, S, G, dh = kv.shape
    c = kv.reshape(B, S // CMP_STRIDE, CMP_STRIDE, G, dh)
    blk = jnp.concatenate([c[:, :-1], c[:, 1:]], axis=2)
    blk = blk + pos[:, None, :]
    nc = blk.shape[1]
    blk = blk.transpose(0, 1, 3, 2, 4).reshape(B, nc, G, CMP_LEN * dh)
    return jax.nn.gelu(blk @ w1) @ w2


def nsa(q, kc, vc, ks, vs, kw, vw, gates, slopes):
    B, S = q.shape[0], q.shape[1]
    G, R, dh = N_KV_GROUPS, HEADS_PER_GROUP, HEAD_DIM
    NQ = S // Q_BLOCK
    NB = S // SEL_LEN
    NC = kc.shape[1]
    topk = min(SEL_TOPK, NB)
    scale = HEAD_DIM ** -0.5
    slopes_g = slopes.reshape(G, R)[None, :, :, None, None]
    cmp_end = jnp.arange(NC) * CMP_STRIDE + (CMP_LEN - 1)
    kc_t = kc.transpose(0, 2, 1, 3)
    vc_t = vc.transpose(0, 2, 1, 3)
    ks_blk = ks.reshape(B, NB, SEL_LEN, G, dh).transpose(0, 3, 1, 2, 4)
    vs_blk = vs.reshape(B, NB, SEL_LEN, G, dh).transpose(0, 3, 1, 2, 4)
    kw_pad = jnp.pad(kw, ((0, 0), (WINDOW, 0), (0, 0), (0, 0)))
    vw_pad = jnp.pad(vw, ((0, 0), (WINDOW, 0), (0, 0), (0, 0)))
    q_blocks = q.reshape(B, NQ, Q_BLOCK, G, R, dh).transpose(1, 0, 2, 3, 4, 5)
    g_blocks = gates.reshape(B, NQ, Q_BLOCK, G, R, 3).transpose(1, 0, 2, 3, 4, 5)
    gather = jax.vmap(jax.vmap(lambda kb, idx: kb[idx]))
    blk_ids = jnp.arange(NB)

    def one_block(args):
        qb, qi, gi = args
        q0 = qb * Q_BLOCK
        t = q0 + jnp.arange(Q_BLOCK)
        qf = qi * scale
        dist_c = t[:, None] - cmp_end[None, :]
        s = jnp.einsum('bqgrd,bgcd->bgrqc', qf, kc_t) - slopes_g * dist_c
        p_cmp = masked_softmax(s, dist_c >= 0)
        o_cmp = jnp.einsum('bgrqc,bgcd->bqgrd', p_cmp.astype(vc_t.dtype), vc_t)
        imp = jnp.sum(p_cmp, axis=2)
        left = R_CMP - 1
        imp = jnp.pad(imp, ((0, 0), (0, 0), (0, 0), (left, R_SEL * NB - NC)))
        imp_slc = jnp.zeros(imp.shape[:3] + (NB,), jnp.float32)
        for m in range(R_SEL):
            for n in range(R_CMP):
                st = m - n + left
                imp_slc = imp_slc + imp[..., st:st + R_SEL * NB:R_SEL]
        cur = t // SEL_LEN
        valid = blk_ids[None, :] * SEL_LEN <= t[:, None]
        forced = (blk_ids[None, :] == 0) | (blk_ids[None, :] == cur[:, None]) | (blk_ids[None, :] == cur[:, None] - 1)
        score = jnp.where(valid, imp_slc, -1.0)
        score = jnp.where(forced & valid, FORCE_SCORE, score)
        _, idx = lax.top_k(score, topk)
        k_sel = gather(ks_blk, idx).reshape(B, G, Q_BLOCK, topk * SEL_LEN, dh)
        v_sel = gather(vs_blk, idx).reshape(B, G, Q_BLOCK, topk * SEL_LEN, dh)
        pos = (idx[..., None] * SEL_LEN + jnp.arange(SEL_LEN)).reshape(B, G, Q_BLOCK, topk * SEL_LEN)
        dist_s = t[None, None, :, None] - pos
        s = jnp.einsum('bqgrd,bgqkd->bgrqk', qf, k_sel) - slopes_g * dist_s[:, :, None]
        p_sel = masked_softmax(s, (dist_s >= 0)[:, :, None])
        o_slc = jnp.einsum('bgrqk,bgqkd->bqgrd', p_sel.astype(v_sel.dtype), v_sel)
        kwin = lax.dynamic_slice_in_dim(kw_pad, q0, WINDOW + Q_BLOCK, axis=1)
        vwin = lax.dynamic_slice_in_dim(vw_pad, q0, WINDOW + Q_BLOCK, axis=1)
        pos_w = q0 - WINDOW + jnp.arange(WINDOW + Q_BLOCK)
        dist_w = t[:, None] - pos_w[None, :]
        mask_w = (dist_w >= 0) & (dist_w < WINDOW) & (pos_w[None, :] >= 0)
        s = jnp.einsum('bqgrd,bkgd->bgrqk', qf, kwin) - slopes_g * dist_w
        p_win = masked_softmax(s, mask_w)
        o_win = jnp.einsum('bgrqk,bkgd->bqgrd', p_win.astype(vwin.dtype), vwin)
        g = jax.nn.sigmoid(gi)
        return g[..., 0:1] * o_cmp + g[..., 1:2] * o_slc + g[..., 2:3] * o_win

    o = lax.map(one_block, (jnp.arange(NQ), q_blocks, g_blocks))
    return o.transpose(1, 0, 2, 3, 4, 5).reshape(B, S, D_ATTN)


def setup_inputs(seed: int = 0) -> dict:
    key = jax.random.key(seed)
    ks = jax.random.split(key, 32)
    f32 = jnp.float32

    def nrm(k, shape, fan_in):
        return jax.random.normal(k, shape, f32) * (fan_in ** -0.5)

    def gain(k):
        return 1.0 + 0.05 * jax.random.normal(k, (DEPTH, D_MODEL), f32)

    u = jax.random.uniform(ks[10], (DEPTH, D_RNN), f32, minval=0.9, maxval=0.999)
    s = u ** (1.0 / LRU_C)
    lam = jnp.log(s) - jnp.log1p(-s)
    return {
        'x': jax.random.normal(ks[0], (BATCH, SEQ, D_MODEL), f32),
        'p': jax.random.normal(ks[1], (DEPTH, BATCH, SEQ, D_PLE), f32),
        'norm_mix_pre': gain(ks[2]),
        'norm_mix_post': gain(ks[3]),
        'w_in': nrm(ks[4], (DEPTH, D_MODEL, D_IN), D_MODEL),
        'conv_w': nrm(ks[5], (DEPTH, CONV_WIDTH, D_RNN), CONV_WIDTH),
        'conv_b': 0.02 * jax.random.normal(ks[6], (DEPTH, D_RNN), f32),
        'lru_wa': nrm(ks[7], (DEPTH, N_LRU_BLOCKS, LRU_BLOCK, LRU_BLOCK), LRU_BLOCK),
        'lru_ba': 0.02 * jax.random.normal(ks[8], (DEPTH, D_RNN), f32),
        'lru_wx': nrm(ks[9], (DEPTH, N_LRU_BLOCKS, LRU_BLOCK, LRU_BLOCK), LRU_BLOCK),
        'lru_bx': 0.02 * jax.random.normal(ks[11], (DEPTH, D_RNN), f32),
        'lru_lambda': lam,
        'cmp_pos_k': 0.02 * jax.random.normal(ks[12], (DEPTH, CMP_LEN, HEAD_DIM), f32),
        'cmp_pos_v': 0.02 * jax.random.normal(ks[13], (DEPTH, CMP_LEN, HEAD_DIM), f32),
        'cmp_k_w1': nrm(ks[14], (DEPTH, CMP_LEN * HEAD_DIM, CMP_HIDDEN), CMP_LEN * HEAD_DIM),
        'cmp_k_w2': nrm(ks[15], (DEPTH, CMP_HIDDEN, HEAD_DIM), CMP_HIDDEN),
        'cmp_v_w1': nrm(ks[16], (DEPTH, CMP_LEN * HEAD_DIM, CMP_HIDDEN), CMP_LEN * HEAD_DIM),
        'cmp_v_w2': nrm(ks[17], (DEPTH, CMP_HIDDEN, HEAD_DIM), CMP_HIDDEN),
        'w_out': nrm(ks[18], (DEPTH, D_MODEL, D_MODEL), D_MODEL),
        'norm_ffn_pre': gain(ks[19]),
        'norm_ffn_post': gain(ks[20]),
        'ffn_w_gate_up': nrm(ks[21], (DEPTH, D_MODEL, 2 * D_FF), D_MODEL),
        'ffn_w_down': nrm(ks[22], (DEPTH, D_FF, D_MODEL), D_FF),
        'ple_w_proj': nrm(ks[23], (DEPTH, D_PLE, D_MODEL), D_PLE),
        'ple_w_gate': nrm(ks[24], (DEPTH, D_MODEL, D_MODEL), D_MODEL),
        'ple_b_gate': 0.02 * jax.random.normal(ks[25], (DEPTH, D_MODEL), f32),
    }


def reference(x, p, norm_mix_pre, norm_mix_post, w_in, conv_w, conv_b, lru_wa, lru_ba, lru_wx, lru_bx,
              lru_lambda, cmp_pos_k, cmp_pos_v, cmp_k_w1, cmp_k_w2, cmp_v_w1, cmp_v_w2, w_out,
              norm_ffn_pre, norm_ffn_post, ffn_w_gate_up, ffn_w_down, ple_w_proj, ple_w_gate, ple_b_gate):
    B, S, _ = x.shape
    slopes = alibi_slopes()
    for i in range(DEPTH):
        h = rmsnorm(x, norm_mix_pre[i])
        z = h @ w_in[i]
        xr, gr, q, kc, vc, ksl, vsl, kw, vw, g_nsa, gm_rnn, gm_attn = jnp.split(z, IN_SPLITS, axis=-1)
        xr = causal_conv(xr, conv_w[i], conv_b[i])
        y_rnn = rg_lru(xr, lru_wa[i], lru_ba[i], lru_wx[i], lru_bx[i], lru_lambda[i]) * jax.nn.gelu(gr)
        kv_shape = (B, S, N_KV_GROUPS, HEAD_DIM)
        kc_c = compress(kc.reshape(kv_shape), cmp_pos_k[i], cmp_k_w1[i], cmp_k_w2[i])
        vc_c = compress(vc.reshape(kv_shape), cmp_pos_v[i], cmp_v_w1[i], cmp_v_w2[i])
        y_attn = nsa(q, kc_c, vc_c, ksl.reshape(kv_shape), vsl.reshape(kv_shape),
                     kw.reshape(kv_shape), vw.reshape(kv_shape), g_nsa, slopes)
        y = jax.nn.sigmoid(gm_rnn) * y_rnn + jax.nn.sigmoid(gm_attn) * y_attn
        x = x + rmsnorm(y @ w_out[i], norm_mix_post[i])
        h = rmsnorm(x, norm_ffn_pre[i])
        gate, up = jnp.split(h @ ffn_w_gate_up[i], 2, axis=-1)
        x = x + rmsnorm((jax.nn.silu(gate) * up) @ ffn_w_down[i], norm_ffn_post[i])
        x = x + jax.nn.sigmoid(x @ ple_w_gate[i] + ple_b_gate[i]) * (p[i] @ ple_w_proj[i])
    return x
```

```cpp
#include <hip/hip_runtime.h>
#include <hip/hip_cooperative_groups.h>
#include <cstdio>
#include <cstdint>
namespace cg = cooperative_groups;
#ifndef DRYV
#define DRYV 0
#endif
#ifndef DRYMODE
#define DRYMODE 1
#endif
#ifndef PROBE_MASK
#define PROBE_MASK 0x0
#endif

#define LAS __attribute__((address_space(3)))
#define DI __device__ __forceinline__
typedef unsigned short bf16;
typedef short bf16x8 __attribute__((ext_vector_type(8)));
typedef short s16x4 __attribute__((ext_vector_type(4)));
typedef float f32x4 __attribute__((ext_vector_type(4)));
typedef float f32x16 __attribute__((ext_vector_type(16)));
typedef unsigned u32x4 __attribute__((ext_vector_type(4)));
typedef unsigned u32x2 __attribute__((ext_vector_type(2)));
typedef unsigned long long u64;

constexpr int NB = 8, SEQ = 8192, DM = 1024, MTOK = NB * SEQ, DFF = 2816, DPLE = 256, DIN = 6704;
constexpr int NWAVES = 8, NTHR = 512;
constexpr float NORM_EPS = 1e-6f;
constexpr float LOG2E = 1.4426950408889634f;

constexpr size_t MiB = (size_t)1 << 20, KiB = 1024;
constexpr size_t WS_WIN = 0;
constexpr size_t WS_WV = WS_WIN + (size_t)6400 * 2048;
constexpr size_t WS_WOUT = 14 * MiB, WS_WGU = 16 * MiB, WS_WDN = 27 * MiB, WS_WPG = 33 * MiB, WS_WPP = 35 * MiB;
constexpr size_t WS_CW1K = 36 * MiB, WS_CW1V = 37 * MiB, WS_CW2K = 38 * MiB, WS_CW2V = 38 * MiB + 128 * KiB;
constexpr size_t WS_LWA = 38 * MiB + 256 * KiB, WS_LWX = 38 * MiB + 384 * KiB, WS_POSB = 38 * MiB + 512 * KiB;
constexpr size_t WS_PART = 63 * MiB, WS_POSBP = 63 * MiB + 512 * KiB;
constexpr size_t WS_CTR = 38 * MiB + 768 * KiB, WS_BAR = WS_CTR + 16 * KiB, CTL_BYTES = 32 * KiB;
constexpr size_t WS_AGG = 39 * MiB;
constexpr size_t WS_HIDK = 43 * MiB, WS_HIDV = 51 * MiB;
constexpr size_t WS_KCC = 59 * MiB, WS_VCT = 61 * MiB;
constexpr size_t WS_XR = 64 * MiB, WS_GR = 192 * MiB, WS_Q = 320 * MiB, WS_KC = 448 * MiB, WS_VC = 480 * MiB, WS_KSL = 512 * MiB, WS_KW = 544 * MiB;
constexpr size_t WS_GMA = 576 * MiB, WS_GNSA = 704 * MiB, WS_VTSL = 712 * MiB, WS_VTW = 744 * MiB;
constexpr size_t WS_RAW = 64 * MiB, WS_H2 = 192 * MiB, WS_ACT = 320 * MiB, WS_PB = 672 * MiB, WS_PP = 704 * MiB;
constexpr size_t WS_CT = 832 * MiB;
constexpr size_t WS_CARRY = 39 * MiB;
constexpr size_t WS_AGG2 = 960 * MiB;
constexpr size_t WS_END = 964 * MiB;

constexpr int LDS_BYTES = 163840;

typedef __bf16 bf16x2_t __attribute__((ext_vector_type(2)));
typedef float f32x2_t __attribute__((ext_vector_type(2)));
DI unsigned pk2(float lo, float hi) { const f32x2_t v = {lo, hi}; const bf16x2_t b = __builtin_convertvector(v, bf16x2_t); return __builtin_bit_cast(unsigned, b); }
DI unsigned f2bf(float f) { return pk2(f, 0.f) & 0xffffu; }
DI float bf2f(unsigned b) { return __builtin_bit_cast(float, b << 16); }
DI float bflo(unsigned w) { return __builtin_bit_cast(float, w << 16); }
DI float bfhi(unsigned w) { return __builtin_bit_cast(float, w & 0xffff0000u); }
DI float sigmoidf_(float x) { return __builtin_amdgcn_rcpf(1.f + __builtin_amdgcn_exp2f(fminf(-x * LOG2E, 126.f))); }
DI float gelu_tanh(float x) { const float u = 0.7978845608028654f * (x + 0.044715f * x * x * x); return x * sigmoidf_(2.f * u); }
template <int CTRL> DI float dpp_f(float x) { return __builtin_bit_cast(float, __builtin_amdgcn_update_dpp(0, __builtin_bit_cast(int, x), CTRL, 0xF, 0xF, true)); }
template <int CTRL> DI int dpp_i(int x) { return __builtin_amdgcn_update_dpp(0, x, CTRL, 0xF, 0xF, true); }
DI float wave_sum(float v) {
#pragma unroll
    for (int o = 1; o < 64; o <<= 1) v += __shfl_xor(v, o);
    return v;
}
DI int lane_id() { int l; asm volatile("v_mbcnt_lo_u32_b32 %0, -1, 0\n\tv_mbcnt_hi_u32_b32 %0, -1, %0" : "=v"(l)); return l; }
#define TIDX (wv * 64 + lane_id())
DI void grid_sync_(const int wv) {
    __builtin_amdgcn_fence(__ATOMIC_RELEASE, "workgroup");
    __builtin_amdgcn_s_barrier();
    if (wv == 0) {
        if (lane_id() == 0) {
            __builtin_amdgcn_fence(__ATOMIC_ACQUIRE, "workgroup");
            __builtin_amdgcn_fence(__ATOMIC_RELEASE, "agent");
            const __attribute__((address_space(4))) char* ia = (const __attribute__((address_space(4))) char*)__builtin_amdgcn_implicitarg_ptr();
            const unsigned long long p = *(const __attribute__((address_space(4))) unsigned long long*)(ia + 88);
            unsigned* cnt = (unsigned*)(p + 32);
            const unsigned n = *(const unsigned*)(p + 40);
            const unsigned v = __hip_atomic_fetch_add(cnt, 1u, __ATOMIC_RELAXED, __HIP_MEMORY_SCOPE_AGENT);
            if ((v & 0xffffu) == n - 1u) (void)__hip_atomic_fetch_add(cnt, 65536u - n, __ATOMIC_RELAXED, __HIP_MEMORY_SCOPE_AGENT);
            const unsigned gen = v & 0xffff0000u;
            while ((__hip_atomic_load(cnt, __ATOMIC_RELAXED, __HIP_MEMORY_SCOPE_AGENT) & 0xffff0000u) == gen) __builtin_amdgcn_s_sleep(1);
            __builtin_amdgcn_fence(__ATOMIC_ACQUIRE, "agent");
            __builtin_amdgcn_fence(__ATOMIC_RELEASE, "workgroup");
        }
    }
    __builtin_amdgcn_s_barrier();
    __builtin_amdgcn_fence(__ATOMIC_ACQUIRE, "workgroup");
}
constexpr int LDS_SLOT = 155648;
DI int next_item(const int wv, LAS unsigned char* lds, unsigned* ctr) {
    __syncthreads();
    if (wv == 0) { if (lane_id() == 0) *(volatile LAS int*)(lds + LDS_SLOT) = (int)__hip_atomic_fetch_add(ctr, 1u, __ATOMIC_RELAXED, __HIP_MEMORY_SCOPE_AGENT); }
    __syncthreads();
    return *(volatile LAS int*)(lds + LDS_SLOT);
}

#define XB_TMO      128
#define XB_XCNT(j)  (256  + 64 * (j))
#define XB_XSUB(j)  (1280 + 64 * (j))
#define XB_XGEN(j)  (2304 + 64 * (j))
#define XB_TOP      3328
#define XB_TOPGEN   3392
#define XCD_BAR_WORDS 3456
#define XB_SPIN_CAP (1u << 22)
DI unsigned xb_ld(unsigned* p)              { return __hip_atomic_load(p, __ATOMIC_RELAXED, __HIP_MEMORY_SCOPE_AGENT); }
DI unsigned xb_add(unsigned* p, unsigned v) { return __hip_atomic_fetch_add(p, v, __ATOMIC_RELAXED, __HIP_MEMORY_SCOPE_AGENT); }
DI unsigned xb_xcc_id() { return (unsigned)__builtin_amdgcn_s_getreg((3 << 11) | 20) & 0xFu; }
#define XB_SPIN(cond, bar) do { unsigned _sp = 0; while (cond) { __builtin_amdgcn_s_sleep(1); \
    if ((++_sp & 255u) == 0u) { if (xb_ld(&(bar)[XB_TMO])) break; if (_sp > XB_SPIN_CAP) { atomicAdd(&(bar)[XB_TMO], 1u); break; } } } } while (0)
DI void xcd_barrier_complete(unsigned* bar, unsigned x, unsigned& nloc, unsigned& nx) {
    const unsigned G = gridDim.x * gridDim.y * gridDim.z;
    unsigned sum, cnt, mine, sp = 0u;
    for (;;) {
        sum = 0u; cnt = 0u; mine = 0u;
#pragma unroll
        for (unsigned j = 0; j < 16; ++j) { const unsigned c = xb_ld(&bar[XB_XCNT(j)]); sum += c; cnt += (c > 0u) ? 1u : 0u; mine = (j == x) ? c : mine; }
        if (sum == G) break;
        __builtin_amdgcn_s_sleep(1);
        if ((++sp & 255u) == 0u) { if (xb_ld(&bar[XB_TMO])) break; if (sp > XB_SPIN_CAP) { atomicAdd(&bar[XB_TMO], 1u); break; } }
    }
    nloc = mine > 0u ? mine : 1u; nx = cnt > 0u ? cnt : 1u;
}
DI void xcd_barrier(const int wv, unsigned* bar, const unsigned x, volatile LAS unsigned* st) {
    asm volatile("s_waitcnt vmcnt(0)" ::: "memory");
    __syncthreads();
    if (wv == 0) { if (lane_id() == 0) {
        __builtin_amdgcn_s_waitcnt(0);
        unsigned nloc = st[0], nx = st[1];
        if (nloc == 0u) { xcd_barrier_complete(bar, x, nloc, nx); st[0] = nloc; st[1] = nx; }
        const unsigned old = xb_add(&bar[XB_XSUB(x)], 1u);
        const unsigned gen = old / nloc;
        if (old + 1u == (gen + 1u) * nloc) {
            __builtin_amdgcn_fence(__ATOMIC_RELEASE, "agent");
            asm volatile("s_waitcnt vmcnt(0)" ::: "memory");
            const unsigned og = xb_add(&bar[XB_TOP], 1u);
            const unsigned tg = og / nx;
            if (og + 1u == (tg + 1u) * nx) xb_add(&bar[XB_TOPGEN], 1u);
            else XB_SPIN(xb_ld(&bar[XB_TOPGEN]) == tg, bar);
            __builtin_amdgcn_fence(__ATOMIC_ACQUIRE, "agent");
            xb_add(&bar[XB_XGEN(x)], 1u);
            asm volatile("s_waitcnt vmcnt(0)" ::: "memory");
        } else {
            XB_SPIN(xb_ld(&bar[XB_XGEN(x)]) == gen, bar);
            __builtin_amdgcn_fence(__ATOMIC_ACQUIRE, "agent");
            asm volatile("s_waitcnt vmcnt(0)" ::: "memory");
        }
    } }
    __syncthreads();
}
#define LDS_WAIT() asm volatile("s_waitcnt lgkmcnt(0)" ::: "memory")

namespace pg8 {
constexpr int BM = 256, BK = 64, HALF = 128, HTB = HALF * BK * 2, NXCD = 8, WGM = 8;
DI int lds_byte(int r, int c) { const int st = (r >> 4) * 2 + (c >> 5), rr = r & 15, cc = c & 31, ob = rr * 64 + cc * 2; return st * 1024 + (ob ^ (((ob >> 9) & 1) << 5)); }
DI void stage_rc(int b, int& R, int& C) { const int st = b / 1024, sb = b % 1024, swz = sb ^ (((sb >> 9) & 1) << 5); R = (st >> 1) * 16 + swz / 64; C = (st & 1) * 32 + (swz % 64) / 2; }
DI int perm32(int rho) { const int n = rho >> 4, i = rho & 15; return 8 * (i >> 2) + 4 * n + (i & 3); }
struct Unit { int pm, pn; };
struct Sched {
    int nM, nN, nwg, G, c;
    DI void init(int nM_, int nN_, int G_, int c_) { nM = nM_; nN = nN_; nwg = nM * nN; G = G_; c = c_; }
    DI bool next(int i, Unit& u) const {
        const long L = (long)i * G + c; if (L >= nwg) return false;
        int wgid = (int)L; { const int q = nwg / NXCD, r = nwg % NXCD, xcd = wgid % NXCD, off = wgid / NXCD; wgid = (xcd < r ? xcd * (q + 1) : r * (q + 1) + (xcd - r) * q) + off; }
        const int nig = WGM * nN, gid = wgid / nig, fm = gid * WGM, gsz = (nM - fm) < WGM ? (nM - fm) : WGM;
        u.pm = fm + ((wgid % nig) % gsz); u.pn = (wgid % nig) / gsz; return true;
    }
};
struct GemmD {
    const char* A; const char* Bt; int K; unsigned lda, ldb, kstepA, kstepB; int amode;
    DI const char* a(const Unit& u) const {
        if (amode == 1) return A + (((size_t)(u.pm & 15) * 256 * 16 * 256) + (size_t)(u.pm >> 4) * 64) * 2;
        return A + (size_t)u.pm * 256 * lda * 2;
    }
    DI const char* b(const Unit& u) const { return Bt + (size_t)u.pn * 256 * ldb * 2; }
};

template <class Epi, bool ALIGN_EPI>
DI void gemm_phase(const int wv, LAS unsigned char* lds, const GemmD g, const Sched& S, const Epi& E) {
    const int tid = TIDX, wid = wv, lane = tid & 63, wr = wid >> 2, wc = wid & 3, fr = lane & 15, fq = lane >> 4;
    const int nt = g.K / BK;
    unsigned voffA[2], voffB[2];
#pragma unroll
    for (int i = 0; i < 2; ++i) { int R, C; stage_rc(tid * 16 + i * 8192, R, C); const int Rb = (R & ~31) + perm32(R & 31);
        voffA[i] = (unsigned)(R * g.lda + C) * 2u; voffB[i] = (unsigned)(Rb * g.ldb + C) * 2u; }
    const size_t kstepA = g.kstepA, kstepB = g.kstepB;
    const size_t hstepA = (size_t)HALF * g.lda * 2, hstepB = (size_t)HALF * g.ldb * 2;
    const unsigned ldsw = (unsigned)wid * 1024u;
    const int aoff = lds_byte(wr * 64 + fr, fq * 8), boff = lds_byte(wc * 32 + fr, fq * 8);
#define PG8_SA(b, h) (((b) * 2 + (h)) * HTB)
#define PG8_SB(b, h) ((4 + (b) * 2 + (h)) * HTB)
#define PG8_STAGE(bufoff, gbase, voff) do { _Pragma("unroll") for (int _i = 0; _i < 2; ++_i) \
        __builtin_amdgcn_global_load_lds((const unsigned*)((const char*)(gbase) + (voff)[_i]), (LAS unsigned*)(lds + (bufoff) + ldsw + _i * 8192), 16, 0, 0); } while (0)
#define PG8_LDA(dst, b, h) do { _Pragma("unroll") for (int m = 0; m < 4; ++m) _Pragma("unroll") for (int k = 0; k < 2; ++k) dst[m][k] = *(const LAS bf16x8*)(lds + PG8_SA(b, h) + aoff + m * 2048 + k * 1024); } while (0)
#define PG8_LDB(dst, b, h) do { _Pragma("unroll") for (int n = 0; n < 2; ++n) _Pragma("unroll") for (int k = 0; k < 2; ++k) dst[n][k] = *(const LAS bf16x8*)(lds + PG8_SB(b, h) + boff + n * 2048 + k * 1024); } while (0)
#define PG8_MMA(ai, bj, At, Bt) do { __builtin_amdgcn_s_setprio(1); _Pragma("unroll") for (int m = 0; m < 4; ++m) _Pragma("unroll") for (int n = 0; n < 2; ++n) _Pragma("unroll") for (int k = 0; k < 2; ++k) \
        acc[ai][bj][m][n] = __builtin_amdgcn_mfma_f32_16x16x32_bf16(Bt[n][k], At[m][k], acc[ai][bj][m][n], 0, 0, 0); __builtin_amdgcn_s_setprio(0); } while (0)
#define PG8_WAIT_V(n) asm volatile("s_waitcnt vmcnt(" #n ")" ::: "memory")
#define PG8_WAIT_L(n) asm volatile("s_waitcnt lgkmcnt(" #n ")" ::: "memory")
#define PG8_BAR __builtin_amdgcn_s_barrier()
#define PG8_SCHED __builtin_amdgcn_sched_barrier(0)
    Unit cur, nxt; int ui = 0;
    if (!S.next(0, cur)) return;
    f32x4 acc[2][2][4][2];
#pragma unroll
    for (int a = 0; a < 2; ++a)
#pragma unroll
        for (int b = 0; b < 2; ++b)
#pragma unroll
            for (int m = 0; m < 4; ++m)
#pragma unroll
                for (int n = 0; n < 2; ++n) acc[a][b][m][n] = (f32x4){0.f, 0.f, 0.f, 0.f};
    bf16x8 At[4][2], B0[2][2], B1[2][2];
    const char* cA = g.a(cur); const char* cB = g.b(cur);
    PG8_STAGE(PG8_SB(0, 0), cB, voffB); PG8_STAGE(PG8_SB(0, 1), cB + hstepB, voffB); PG8_STAGE(PG8_SA(0, 0), cA, voffA); PG8_STAGE(PG8_SA(0, 1), cA + hstepA, voffA);
    if (wr == 1) PG8_BAR;
    PG8_WAIT_V(2); PG8_BAR;
    PG8_STAGE(PG8_SB(1, 0), cB + kstepB, voffB); PG8_STAGE(PG8_SA(1, 0), cA + kstepA, voffA); PG8_STAGE(PG8_SB(1, 1), cB + hstepB + kstepB, voffB);
    PG8_WAIT_V(6); PG8_BAR;
    for (;;) {
        const bool has_next = S.next(ui + 1, nxt);
        const char* nA = has_next ? g.a(nxt) : cA; const char* nB = has_next ? g.b(nxt) : cB;
        for (int t = 0; t < nt; t += 2) {
            const bool last = (t == nt - 2);
            const char* a1 = cA + (size_t)(t + 1) * kstepA;
            const char* a2 = last ? nA : cA + (size_t)(t + 2) * kstepA; const char* b2 = last ? nB : cB + (size_t)(t + 2) * kstepB;
            const char* a3 = a2 + kstepA; const char* b3 = b2 + kstepB;
            PG8_LDB(B0, 0, 0); PG8_LDB(B1, 0, 1); PG8_SCHED; PG8_LDA(At, 0, 0); PG8_STAGE(PG8_SA(1, 1), a1 + hstepA, voffA);
            PG8_WAIT_V(8); PG8_WAIT_L(0); PG8_BAR; PG8_MMA(0, 0, At, B0); PG8_MMA(0, 1, At, B1); PG8_BAR; PG8_SCHED;
            PG8_LDA(At, 0, 1); PG8_STAGE(PG8_SB(0, 0), b2, voffB); PG8_STAGE(PG8_SB(0, 1), b2 + hstepB, voffB); PG8_STAGE(PG8_SA(0, 0), a2, voffA);
            PG8_WAIT_V(8); PG8_WAIT_L(0); PG8_BAR; PG8_MMA(1, 0, At, B0); PG8_MMA(1, 1, At, B1); PG8_BAR; PG8_SCHED;
            PG8_LDB(B0, 1, 0); PG8_LDB(B1, 1, 1); PG8_SCHED; PG8_LDA(At, 1, 0); PG8_STAGE(PG8_SA(0, 1), a2 + hstepA, voffA);
            PG8_WAIT_V(8); PG8_WAIT_L(0); PG8_BAR; PG8_MMA(0, 0, At, B0); PG8_MMA(0, 1, At, B1); PG8_BAR; PG8_SCHED;
            PG8_LDA(At, 1, 1); PG8_STAGE(PG8_SB(1, 0), b3, voffB); PG8_STAGE(PG8_SB(1, 1), b3 + hstepB, voffB); PG8_STAGE(PG8_SA(1, 0), a3, voffA);
            PG8_WAIT_V(8); PG8_WAIT_L(0); PG8_BAR; PG8_MMA(1, 0, At, B0); PG8_MMA(1, 1, At, B1); PG8_BAR; PG8_SCHED;
        }
        if constexpr (ALIGN_EPI) { if (wr == 0) PG8_BAR; }
        E(acc, cur, wr, wc, fr, fq);
        if (!has_next) break;
#pragma unroll
        for (int a = 0; a < 2; ++a)
#pragma unroll
            for (int b = 0; b < 2; ++b)
#pragma unroll
                for (int m = 0; m < 4; ++m)
#pragma unroll
                    for (int n = 0; n < 2; ++n) acc[a][b][m][n] = (f32x4){0.f, 0.f, 0.f, 0.f};
        cur = nxt; cA = nA; cB = nB; ++ui;
        if constexpr (ALIGN_EPI) { if (wr == 1) PG8_BAR; }
    }
    PG8_WAIT_V(0);
    if constexpr (!ALIGN_EPI) { if (wr == 0) PG8_BAR; }
    PG8_BAR;
#undef PG8_SA
#undef PG8_SB
#undef PG8_STAGE
#undef PG8_LDA
#undef PG8_LDB
#undef PG8_MMA
#undef PG8_WAIT_V
#undef PG8_WAIT_L
#undef PG8_BAR
#undef PG8_SCHED
}

#define EPI_LOOP for (int ai = 0; ai < 2; ++ai) _Pragma("unroll") for (int m = 0; m < 4; ++m) _Pragma("unroll") for (int bj = 0; bj < 2; ++bj)
DI u32x4 pack8(const f32x4 v0, const f32x4 v1) { u32x4 w; w.x = pk2(v0[0], v0[1]); w.y = pk2(v0[2], v0[3]); w.z = pk2(v1[0], v1[1]); w.w = pk2(v1[2], v1[3]); return w; }

template <int ACT, int ZM> struct EpiStore {
    bf16* O; size_t ld; const float* bias; int row_valid, col_valid;
    DI void operator()(const f32x4 (&acc)[2][2][4][2], const Unit& u, int wr, int wc, int fr, int fq) const {
#pragma unroll
        EPI_LOOP {
            const int row = u.pm * 256 + ai * 128 + wr * 64 + m * 16 + fr, col0 = u.pn * 256 + bj * 128 + wc * 32 + 8 * fq;
            if (row < row_valid && col0 < col_valid) {
                f32x4 v0 = acc[ai][bj][m][0], v1 = acc[ai][bj][m][1];
                if (bias) { v0 += *(const f32x4*)(bias + col0); v1 += *(const f32x4*)(bias + col0 + 4); }
                if (ACT == 1) {
#pragma unroll
                    for (int i = 0; i < 4; ++i) { v0[i] = gelu_tanh(v0[i]); v1[i] = gelu_tanh(v1[i]); }
                }
                if (ZM == 1) { if ((row & 511) == 511) { v0 = (f32x4){0.f, 0.f, 0.f, 0.f}; v1 = v0; } }
                if (ZM == 2) { if (((col0 + 7) & 511) == 511) v1[3] = 0.f; }
                *(u32x4*)(O + (size_t)row * ld + col0) = pack8(v0, v1);
            }
        }
    }
};
struct EpiSec {
    unsigned char* ws; unsigned char* dout;
    DI void operator()(const f32x4 (&acc)[2][2][4][2], const Unit& u, int wr, int wc, int fr, int fq) const {
        const int pn = u.pn; bf16* base; int ld, c0, nc = 256;
        if (pn < 12) { base = (bf16*)(ws + WS_XR + (size_t)(pn >> 2) * 128 * MiB); ld = 1024; c0 = (pn & 3) * 256; }
        else if (pn < 16) { base = (bf16*)(ws + WS_KC + (size_t)(pn - 12) * 32 * MiB); ld = 256; c0 = 0; }
        else if (pn < 20) { base = (bf16*)(dout + 128 * MiB); ld = 1024; c0 = (pn - 16) * 256; }
        else if (pn < 24) { base = (bf16*)(ws + WS_GMA); ld = 1024; c0 = (pn - 20) * 256; }
        else { base = (bf16*)(ws + WS_GNSA); ld = 64; c0 = 0; nc = 64; }
        const float qs = (pn >= 8 && pn < 12) ? 0.125f * LOG2E : 1.f;
#pragma unroll
        EPI_LOOP {
            const int row = u.pm * 256 + ai * 128 + wr * 64 + m * 16 + fr, cl = bj * 128 + wc * 32 + 8 * fq;
            if (cl < nc) __builtin_nontemporal_store(pack8(acc[ai][bj][m][0] * qs, acc[ai][bj][m][1] * qs), (u32x4*)(base + (size_t)row * ld + c0 + cl));
        }
    }
};
struct EpiSwi {
    bf16* O;
    DI void operator()(const f32x4 (&acc)[2][2][4][2], const Unit& u, int wr, int wc, int fr, int fq) const {
#pragma unroll
        for (int ai = 0; ai < 2; ++ai)
#pragma unroll
            for (int m = 0; m < 4; ++m) {
                const int row = u.pm * 256 + ai * 128 + wr * 64 + m * 16 + fr, col0 = u.pn * 128 + wc * 32 + 8 * fq;
                f32x4 v0, v1;
#pragma unroll
                for (int i = 0; i < 4; ++i) { const float g0 = acc[ai][0][m][0][i], g1 = acc[ai][0][m][1][i];
                    v0[i] = g0 * sigmoidf_(g0) * acc[ai][1][m][0][i]; v1[i] = g1 * sigmoidf_(g1) * acc[ai][1][m][1][i]; }
                __builtin_nontemporal_store(pack8(v0, v1), (u32x4*)(O + (size_t)row * DFF + col0));
                asm volatile("" ::: "memory");
            }
    }
};
struct EpiPle {
    float* out; const bf16* xb; const bf16* pp; const float* bias;
    DI void operator()(const f32x4 (&acc)[2][2][4][2], const Unit& u, int wr, int wc, int fr, int fq) const {
        f32x4 b0[2], b1[2];
#pragma unroll
        for (int bj = 0; bj < 2; ++bj) { const int col0 = u.pn * 256 + bj * 128 + wc * 32 + 8 * fq; b0[bj] = *(const f32x4*)(bias + col0); b1[bj] = *(const f32x4*)(bias + col0 + 4); }
#pragma unroll
        for (int ai = 0; ai < 2; ++ai) {
            u32x4 pw[4][2], xw[4][2];
#pragma unroll
            for (int m = 0; m < 4; ++m)
#pragma unroll
                for (int bj = 0; bj < 2; ++bj) {
                    const size_t off = (size_t)(u.pm * 256 + ai * 128 + wr * 64 + m * 16 + fr) * DM + u.pn * 256 + bj * 128 + wc * 32 + 8 * fq;
                    pw[m][bj] = *(const u32x4*)(pp + off); xw[m][bj] = *(const u32x4*)(xb + off);
                }
#pragma unroll
            for (int m = 0; m < 4; ++m)
#pragma unroll
                for (int bj = 0; bj < 2; ++bj) {
                    const size_t off = (size_t)(u.pm * 256 + ai * 128 + wr * 64 + m * 16 + fr) * DM + u.pn * 256 + bj * 128 + wc * 32 + 8 * fq;
                    const u32x4 p = pw[m][bj], x = xw[m][bj];
                    const f32x4 a0 = acc[ai][bj][m][0] + b0[bj], a1 = acc[ai][bj][m][1] + b1[bj];
                    f32x4 x0, x1;
                    x0[0] = bflo(x.x) + sigmoidf_(a0[0]) * bflo(p.x); x0[1] = bfhi(x.x) + sigmoidf_(a0[1]) * bfhi(p.x); x0[2] = bflo(x.y) + sigmoidf_(a0[2]) * bflo(p.y); x0[3] = bfhi(x.y) + sigmoidf_(a0[3]) * bfhi(p.y);
                    x1[0] = bflo(x.z) + sigmoidf_(a1[0]) * bflo(p.z); x1[1] = bfhi(x.z) + sigmoidf_(a1[1]) * bfhi(p.z); x1[2] = bflo(x.w) + sigmoidf_(a1[2]) * bflo(p.w); x1[3] = bfhi(x.w) + sigmoidf_(a1[3]) * bfhi(p.w);
                    *(f32x4*)(out + off) = x0; *(f32x4*)(out + off + 4) = x1;
                }
        }
    }
};
}

DI int map_row(int mode, int n) {
    if (mode == 1) {
        if (n < 3840) return n;
        if (n < 4096) return 6400 + (n - 3840);
        if (n < 4352) return 3840 + (n - 4096);
        if (n < 4608) return 6656 + (n - 4352);
        if (n < 4656) return 6144 + (n - 4608);
        if (n < 5680) return 4096 + (n - 4656);
        return 5120 + (n - 5680);
    }
    if (mode == 2) {
        if (n < DFF) return 256 * (n >> 7) + (n & 127);
        const int uu = n - DFF; return 256 * (uu >> 7) + 128 + (uu & 127);
    }
    return n;
}
DI void transpose_item(const float* W, int K, int N, bf16* WT, int mode, LAS float* scr, int item, int lane) {
    const int nblk = (N + 31) / 32, kb = item / nblk, nb = item % nblk, k0 = 64 * kb, n0 = 32 * nb;
    const int r8 = lane >> 3, c4 = lane & 7;
    const bool okr = (n0 + 4 * c4) < N;
#pragma unroll
    for (int i = 0; i < 8; ++i) { const int kk = 8 * i + r8;
        const f32x4 v = okr ? *(const f32x4*)(W + (size_t)(k0 + kk) * N + n0 + 4 * c4) : (f32x4){0.f, 0.f, 0.f, 0.f};
        LAS float* d = scr + kk * 33 + 4 * c4; d[0] = v.x; d[1] = v.y; d[2] = v.z; d[3] = v.w; }
    LDS_WAIT(); asm volatile("" ::: "memory");
    const int c = lane & 7;
#pragma unroll
    for (int j = 0; j < 4; ++j) { const int n = (lane >> 3) + 8 * j; const LAS float* s = scr + (8 * c) * 33 + n;
        u32x4 o; o.x = pk2(s[0 * 33], s[1 * 33]); o.y = pk2(s[2 * 33], s[3 * 33]); o.z = pk2(s[4 * 33], s[5 * 33]); o.w = pk2(s[6 * 33], s[7 * 33]);
        if (n0 + n < N) *(u32x4*)(WT + (size_t)map_row(mode, n0 + n) * K + k0 + 8 * c) = o; }
    LDS_WAIT(); asm volatile("" ::: "memory");
}
template <int RR>
DI void rms_rows_to_bf16(const float* X, const float* g, bf16* Out, int m0, int stride, int lane) {
    f32x4 v[RR][4]; float s[RR];
#pragma unroll
    for (int r = 0; r < RR; ++r) { const f32x4* xr = (const f32x4*)(X + (size_t)(m0 + r * stride) * DM) + lane;
#pragma unroll
        for (int j = 0; j < 4; ++j) v[r][j] = xr[64 * j]; }
    f32x4 gg[4];
#pragma unroll
    for (int j = 0; j < 4; ++j) gg[j] = ((const f32x4*)g + lane)[64 * j];
#pragma unroll
    for (int r = 0; r < RR; ++r) { s[r] = 0.f;
#pragma unroll
        for (int j = 0; j < 4; ++j) s[r] += (v[r][j].x * v[r][j].x + v[r][j].y * v[r][j].y) + (v[r][j].z * v[r][j].z + v[r][j].w * v[r][j].w); }
#pragma unroll
    for (int r = 0; r < RR; ++r) {
        const float rs = rsqrtf(wave_sum(s[r]) * (1.f / DM) + NORM_EPS);
        u64* o8 = (u64*)(Out + (size_t)(m0 + r * stride) * DM) + lane;
#pragma unroll
        for (int j = 0; j < 4; ++j) o8[64 * j] = (u64)pk2(v[r][j].x * rs * gg[j].x, v[r][j].y * rs * gg[j].y) | ((u64)pk2(v[r][j].z * rs * gg[j].z, v[r][j].w * rs * gg[j].w) << 32);
    }
}

struct Args { const float* in[26]; float* out; unsigned char* ws; int ph_lo, ph_hi; };

DI void p0_prologue(const int wv, const Args& A, LAS unsigned char* lds, int G) {
    const int tid = TIDX, lane = tid & 63, wave = wv;
    unsigned char* ws = A.ws;
    if (blockIdx.x == 0 && tid < 8) ((unsigned*)(ws + WS_CTR))[tid * 16] = 0u;
    for (int it = blockIdx.x; it < 256; it += G) {
        const int mat = tid >> 8, j = tid & 255;
        const float* pos = A.in[12 + mat]; const float* w1 = A.in[mat ? 16 : 14];
        float s = 0.f;
#pragma unroll
        for (int k = 8 * it; k < 8 * it + 8; ++k) s += pos[k] * w1[(size_t)k * 256 + j];
        ((float*)(ws + WS_PART))[it * 512 + tid] = s;
    }
    LAS float* scr = (LAS float*)(lds + wave * 16384);
    const int gw = blockIdx.x * NWAVES + wave, NGW = G * NWAVES;
    constexpr int I_IN = 16 * 210, I_OUT = 16 * 32, I_GU = 16 * 176, I_DN = 44 * 32, I_PG = 16 * 32, I_PP = 4 * 32, I_C1 = 32 * 8, I_C2 = 4 * 2, I_L = 2;
    constexpr int NITEMS = I_IN + I_OUT + I_GU + I_DN + I_PG + I_PP + 2 * I_C1 + 2 * I_C2 + 32 * I_L;
    for (int it = gw; it < NITEMS; it += NGW) {
        int r = it;
        if (r < I_IN) { transpose_item(A.in[4], DM, DIN, (bf16*)(ws + WS_WIN), 1, scr, r, lane); continue; } r -= I_IN;
        if (r < I_OUT) { transpose_item(A.in[18], DM, DM, (bf16*)(ws + WS_WOUT), 0, scr, r, lane); continue; } r -= I_OUT;
        if (r < I_GU) { transpose_item(A.in[21], DM, 2 * DFF, (bf16*)(ws + WS_WGU), 2, scr, r, lane); continue; } r -= I_GU;
        if (r < I_DN) { transpose_item(A.in[22], DFF, DM, (bf16*)(ws + WS_WDN), 0, scr, r, lane); continue; } r -= I_DN;
        if (r < I_PG) { transpose_item(A.in[24], DM, DM, (bf16*)(ws + WS_WPG), 0, scr, r, lane); continue; } r -= I_PG;
        if (r < I_PP) { transpose_item(A.in[23], DPLE, DM, (bf16*)(ws + WS_WPP), 0, scr, r, lane); continue; } r -= I_PP;
        if (r < I_C1) { transpose_item(A.in[14], 2048, 256, (bf16*)(ws + WS_CW1K), 0, scr, r, lane); continue; } r -= I_C1;
        if (r < I_C1) { transpose_item(A.in[16], 2048, 256, (bf16*)(ws + WS_CW1V), 0, scr, r, lane); continue; } r -= I_C1;
        if (r < I_C2) { transpose_item(A.in[15], 256, 64, (bf16*)(ws + WS_CW2K), 0, scr, r, lane); continue; } r -= I_C2;
        if (r < I_C2) { transpose_item(A.in[17], 256, 64, (bf16*)(ws + WS_CW2V), 0, scr, r, lane); continue; } r -= I_C2;
        { const int mat = r / (16 * I_L), rr = r % (16 * I_L), nb = rr / I_L, sub = rr % I_L;
          transpose_item(A.in[mat ? 9 : 7] + (size_t)nb * 4096, 64, 64, (bf16*)(ws + (mat ? WS_LWX : WS_LWA)) + (size_t)nb * 4096, 0, scr, sub, lane); }
    }
    bf16* H = (bf16*)A.out;
    { int m = gw;
      for (; m + 7 * NGW < MTOK; m += 8 * NGW) rms_rows_to_bf16<8>(A.in[0], A.in[2], H, m, NGW, lane);
      for (; m + 3 * NGW < MTOK; m += 4 * NGW) rms_rows_to_bf16<4>(A.in[0], A.in[2], H, m, NGW, lane);
      for (; m < MTOK; m += NGW) rms_rows_to_bf16<1>(A.in[0], A.in[2], H, m, NGW, lane); }
}

constexpr int SC_W = 18432, SC_SLOT = 16640;
template <int PASS>
DI void scan_item(const int wv, const Args& A, LAS unsigned char* lds, int item) {
    const int tid = TIDX, lane = tid & 63, wave = wv, fr = lane & 15, fq = lane >> 4;
    const int cg8 = item & 7, nblk = (item >> 3) & 15, b = item >> 7;
    const int j = cg8 * 8 + wave, ch = nblk * 64 + lane;
    unsigned char* ws = A.ws;
    const bf16* XR = (const bf16*)(ws + WS_XR); const bf16* GR = (const bf16*)(ws + WS_GR); const bf16* GMR = (const bf16*)((unsigned char*)A.out + 128 * MiB);
    bf16* Y = (bf16*)A.out;
    float2* AGG = (float2*)(ws + WS_AGG2);
    bf16* CT = (bf16*)(ws + WS_CT);
#pragma unroll
    for (int k = 0; k < 2; ++k) { const int id = tid + 512 * k, mat = id >> 9, row = (id >> 3) & 63, c8 = id & 7;
        const bf16* src = (const bf16*)(ws + (mat ? WS_LWX : WS_LWA)) + (size_t)nblk * 4096 + row * 64 + c8 * 8;
        *(LAS u32x4*)(lds + mat * 9216 + row * 144 + c8 * 16) = *(const u32x4*)src; }
    LAS unsigned char* wl = lds + SC_W + wave * SC_SLOT;
    LAS float* pre_r = (LAS float*)wl;
    LAS float* pre_i = (LAS float*)(wl + 4096);
    LAS bf16* xcb = (LAS bf16*)(wl + 8192);
    LAS bf16* SX = (LAS bf16*)(wl + 10496);
    LAS bf16* SG = (LAS bf16*)(wl + 12544);
    LAS bf16* SM = (LAS bf16*)(wl + 14592);
    const float cw0 = A.in[5][ch], cw1 = A.in[5][DM + ch], cw2 = A.in[5][2 * DM + ch], cw3 = A.in[5][3 * DM + ch], cb = A.in[6][ch];
    const float ba = A.in[8][ch], bx = A.in[10][ch];
    const float sp8 = -8.f * log1pf(__expf(-A.in[11][ch]));
    const int t0 = j * 128;
    const size_t rowb = (size_t)b * SEQ;
    float xm3 = 0.f, xm2 = 0.f, xm1 = 0.f;
    if (t0 > 0) { xm3 = bf2f(XR[(rowb + t0 - 3) * DM + ch]); xm2 = bf2f(XR[(rowb + t0 - 2) * DM + ch]); xm1 = bf2f(XR[(rowb + t0 - 1) * DM + ch]); }
    float h = 0.f, P = 1.f;
    const int ptok = lane >> 3, pc8 = lane & 7;
    const size_t gpiece = (size_t)ptok * DM + nblk * 64 + pc8 * 8;
    const int lpiece = ptok * 128 + pc8 * 16;
    u32x4 rx[2], rg[2], rm[2];
#pragma unroll
    for (int k = 0; k < 2; ++k) { const size_t o = (rowb + t0) * DM + gpiece + (size_t)k * 8 * DM;
        rx[k] = *(const u32x4*)(XR + o); rg[k] = *(const u32x4*)(GR + o); rm[k] = *(const u32x4*)(GMR + o); }
    __syncthreads();
    for (int step = 0; step < 8; ++step) {
        const int ts = t0 + step * 16;
#pragma unroll
        for (int k = 0; k < 2; ++k) { *(LAS u32x4*)((LAS unsigned char*)SX + lpiece + k * 1024) = rx[k]; *(LAS u32x4*)((LAS unsigned char*)SG + lpiece + k * 1024) = rg[k]; *(LAS u32x4*)((LAS unsigned char*)SM + lpiece + k * 1024) = rm[k]; }
        if (step < 7) {
#pragma unroll
            for (int k = 0; k < 2; ++k) { const size_t o = (rowb + ts + 16) * DM + gpiece + (size_t)k * 8 * DM;
                rx[k] = *(const u32x4*)(XR + o); rg[k] = *(const u32x4*)(GR + o); rm[k] = *(const u32x4*)(GMR + o); }
        }
        __syncthreads();
        float xc[16];
#pragma unroll
        for (int tt = 0; tt < 16; ++tt) {
            const float x = bf2f(SX[tt * 64 + lane]);
            xc[tt] = cb + cw0 * xm3 + cw1 * xm2 + cw2 * xm1 + cw3 * x;
            xm3 = xm2; xm2 = xm1; xm1 = x;
            xcb[tt * 72 + lane] = (bf16)f2bf(xc[tt]);
        }
        __syncthreads();
        {
            f32x4 ar[4], ai[4];
#pragma unroll
            for (int nt = 0; nt < 4; ++nt) { ar[nt] = (f32x4){0.f, 0.f, 0.f, 0.f}; ai[nt] = ar[nt]; }
#pragma unroll
            for (int ks = 0; ks < 2; ++ks) {
                const bf16x8 af = *(const LAS bf16x8*)(xcb + fr * 72 + ks * 32 + fq * 8);
#pragma unroll
                for (int nt = 0; nt < 4; ++nt) {
                    const bf16x8 wa = *(const LAS bf16x8*)(lds + (nt * 16 + fr) * 144 + ks * 64 + fq * 16);
                    const bf16x8 wx = *(const LAS bf16x8*)(lds + 9216 + (nt * 16 + fr) * 144 + ks * 64 + fq * 16);
                    ar[nt] = __builtin_amdgcn_mfma_f32_16x16x32_bf16(af, wa, ar[nt], 0, 0, 0); ai[nt] = __builtin_amdgcn_mfma_f32_16x16x32_bf16(af, wx, ai[nt], 0, 0, 0); }
            }
#pragma unroll
            for (int nt = 0; nt < 4; ++nt)
#pragma unroll
                for (int q = 0; q < 4; ++q) { pre_r[(fq * 4 + q) * 64 + nt * 16 + fr] = ar[nt][q]; pre_i[(fq * 4 + q) * 64 + nt * 16 + fr] = ai[nt][q]; }
        }
        __syncthreads();
        {
            const f32x2_t ba2 = {ba, ba}, bx2 = {bx, bx}, sp2 = {sp8, sp8}, one2 = {1.f, 1.f};
            const f32x2_t nl2e = {-LOG2E, -LOG2E}, l2e = {LOG2E, LOG2E};
            LAS bf16* SY = SX; LAS bf16* SC = xcb;
#pragma unroll
            for (int tt = 0; tt < 16; tt += 2) {
                const f32x2_t pr = (f32x2_t){pre_r[tt * 64 + lane], pre_r[(tt + 1) * 64 + lane]} + ba2;
                const f32x2_t pi = (f32x2_t){pre_i[tt * 64 + lane], pre_i[(tt + 1) * 64 + lane]} + bx2;
                const f32x2_t cap = {60.f, 60.f};
                const f32x2_t tr = __builtin_elementwise_min(pr * nl2e, cap), ti = __builtin_elementwise_min(pi * nl2e, cap);
                const f32x2_t dr = (f32x2_t){__builtin_amdgcn_exp2f(tr.x), __builtin_amdgcn_exp2f(tr.y)} + one2;
                const f32x2_t di = (f32x2_t){__builtin_amdgcn_exp2f(ti.x), __builtin_amdgcn_exp2f(ti.y)} + one2;
                const f32x2_t dd = dr * di;
                const f32x2_t inv = {__builtin_amdgcn_rcpf(dd.x), __builtin_amdgcn_rcpf(dd.y)};
                const f32x2_t r = inv * di, ig = inv * dr;
                const f32x2_t la = r * sp2;
                const f32x2_t tl = la * l2e;
                const f32x2_t a = {__builtin_amdgcn_exp2f(tl.x), __builtin_amdgcn_exp2f(tl.y)};
                const f32x2_t x2 = la + la;
                f32x2_t om = x2 * (f32x2_t){1.f / 720.f, 1.f / 720.f} + (f32x2_t){1.f / 120.f, 1.f / 120.f};
                om = om * x2 + (f32x2_t){1.f / 24.f, 1.f / 24.f}; om = om * x2 + (f32x2_t){1.f / 6.f, 1.f / 6.f}; om = om * x2 + (f32x2_t){0.5f, 0.5f}; om = om * x2 + one2;
                om = om * (-x2);
                if (__builtin_amdgcn_ballot_w64((x2.x <= -0.25f) || (x2.y <= -0.25f)) != 0ull) {
                    asm volatile("" ::: "memory");
                    if (x2.x <= -0.25f) om.x = 1.f - a.x * a.x;
                    if (x2.y <= -0.25f) om.y = 1.f - a.y * a.y;
                }
                const f32x2_t omx = __builtin_elementwise_max(om, (f32x2_t){0.f, 0.f});
                const f32x2_t sq = {__builtin_amdgcn_sqrtf(omx.x), __builtin_amdgcn_sqrtf(omx.y)};
                const f32x2_t bb = sq * (ig * (f32x2_t){xc[tt], xc[tt + 1]});
                const float h0 = a.x * h + bb.x;
                const float h1 = a.y * h0 + bb.y;
                h = h1;
                const float P0 = P * a.x, P1 = P0 * a.y;
                P = P1;
                const f32x2_t gvv = {bf2f(SG[tt * 64 + lane]), bf2f(SG[(tt + 1) * 64 + lane])}, gmv = {bf2f(SM[tt * 64 + lane]), bf2f(SM[(tt + 1) * 64 + lane])};
                const f32x2_t g2 = gvv * gvv;
                const f32x2_t uu = gvv * (g2 * (f32x2_t){0.044715f, 0.044715f} + one2);
                const f32x2_t tg = __builtin_elementwise_min(uu * (f32x2_t){-2.f * 0.7978845608028654f * LOG2E, -2.f * 0.7978845608028654f * LOG2E}, cap), tm = __builtin_elementwise_min(gmv * nl2e, cap);
                const f32x2_t dg = (f32x2_t){__builtin_amdgcn_exp2f(tg.x), __builtin_amdgcn_exp2f(tg.y)} + one2;
                const f32x2_t dm = (f32x2_t){__builtin_amdgcn_exp2f(tm.x), __builtin_amdgcn_exp2f(tm.y)} + one2;
                const f32x2_t dq = dg * dm;
                const f32x2_t iq = {__builtin_amdgcn_rcpf(dq.x), __builtin_amdgcn_rcpf(dq.y)};
                const f32x2_t gq = gvv * iq;
                const f32x2_t yv = (f32x2_t){h0, h1} * gq, cv = (f32x2_t){P0, P1} * gq;
                SY[tt * 64 + lane] = (bf16)f2bf(yv.x); SY[(tt + 1) * 64 + lane] = (bf16)f2bf(yv.y);
                SC[tt * 64 + lane] = (bf16)f2bf(cv.x); SC[(tt + 1) * 64 + lane] = (bf16)f2bf(cv.y);
            }
        }
        __syncthreads();
#pragma unroll
        for (int k = 0; k < 2; ++k) { const size_t o = (rowb + ts) * DM + gpiece + (size_t)k * 8 * DM;
            *(u32x4*)(Y + o) = *(const LAS u32x4*)((LAS unsigned char*)SX + lpiece + k * 1024);
            *(u32x4*)(CT + o) = *(const LAS u32x4*)((LAS unsigned char*)xcb + lpiece + k * 1024); }
        __syncthreads();
    }
    AGG[((size_t)b * 64 + j) * DM + ch] = make_float2(P, h);
}

struct ACtx { int h, n, qi, r, t, wave; float slope2; unsigned slopew, slope16w; bf16x8 qf[4], akey[2]; u64 sel_lo, sel_hi, wun_lo, wun_hi; };
DI int m128_first(u64 lo, u64 hi) { return lo ? (__ffsll((long long)lo) - 1) : (hi ? 64 + (__ffsll((long long)hi) - 1) : -1); }
DI int m128_last(u64 lo, u64 hi) { return hi ? (127 - __clzll((long long)hi)) : (lo ? (63 - __clzll((long long)lo)) : -1); }
DI bool m128_bit(u64 lo, u64 hi, int j) { return j < 64 ? ((lo >> j) & 1ull) : ((hi >> (j - 64)) & 1ull); }
DI void m128_clear(u64& lo, u64& hi, int j) { if (j < 64) lo &= ~(1ull << j); else hi &= ~(1ull << (j - 64)); }
#define MFMA32(a, b, c) __builtin_amdgcn_mfma_f32_32x32x16_bf16((a), (b), (c), 0, 0, 0)

template <int BR, int NT, int DV>
DI void attn_compute(LAS unsigned char* kbA, LAS unsigned char* vbA, LAS unsigned char* kbB, LAS unsigned char* vbB, const int jA, const int jB,
                     const ACtx& c, const int qb, float& m, float& l, f32x16 (&O)[2], float m_fin, float inv_l, LAS float* imp_row, float& carry) {
    f32x16 s[2 * NT];
#pragma unroll
    for (int ti = 0; ti < NT; ++ti) {
        LAS unsigned char* kb = ti ? kbB : kbA; const int j = ti ? jB : jA;
#pragma unroll
        for (int i = 0; i < 16; ++i) { s[2 * ti][i] = 0.f; s[2 * ti + 1][i] = 0.f; }
#pragma unroll
        for (int ks = 0; ks < ((DV & 4) ? 0 : 4); ++ks) {
            const bf16x8 a0 = *(const LAS bf16x8*)(kb + c.n * 144 + ks * 32 + c.h * 16);
            const bf16x8 a1 = *(const LAS bf16x8*)(kb + (32 + c.n) * 144 + ks * 32 + c.h * 16);
            s[2 * ti] = MFMA32(a0, c.qf[ks], s[2 * ti]); s[2 * ti + 1] = MFMA32(a1, c.qf[ks], s[2 * ti + 1]);
        }
        {
            const int pos0 = (BR <= 1) ? (1024 * j + 31 - c.t) : (64 * j - c.t);
            float tb = c.slope2 * (float)pos0;
            if (BR == 2) { if (!m128_bit(c.sel_lo, c.sel_hi, j)) tb = -1e30f; }
            const unsigned thi = f2bf(tb); const unsigned tlo = f2bf(tb - bf2f(thi));
            u32x4 bw = (u32x4){(BR <= 1) ? c.slope16w : c.slopew, thi | (tlo << 16), 0u, 0u};
            if (c.h) bw = (u32x4){0u, 0u, 0u, 0u};
            const bf16x8 bb = __builtin_bit_cast(bf16x8, bw);
            s[2 * ti] = MFMA32(c.akey[0], bb, s[2 * ti]); s[2 * ti + 1] = MFMA32(c.akey[1], bb, s[2 * ti + 1]);
        }
        bool bnd;
        if (BR <= 1) bnd = (64 * j + 63 > 4 * qb - 2); else if (BR == 2) bnd = (j == qb); else bnd = (j == qb) || (j + 8 == qb);
        if (bnd) {
            asm volatile("" ::: "memory");
            const int d0 = (BR <= 1) ? (c.t - 31 - 1024 * j) : (c.t - 64 * j);
#pragma unroll
            for (int kt = 0; kt < 2; ++kt)
#pragma unroll
                for (int rr = 0; rr < 16; ++rr) {
                    const int key = kt * 32 + (rr & 3) + 8 * (rr >> 2) + 4 * c.h;
                    const int dist = (BR <= 1) ? (d0 - 16 * key) : (d0 - key);
                    bool valid = dist >= 0;
                    if (BR == 3) valid = valid && (dist < 512);
                    s[2 * ti + kt][rr] = valid ? s[2 * ti + kt][rr] : -INFINITY;
                }
        }
    }
    float m_use, alpha = 1.f; bool grow = false;
    float mx = -INFINITY;
#pragma unroll
    for (int q = 0; q < 2 * NT; ++q)
#pragma unroll
        for (int i = 0; i < 16; ++i) mx = fmaxf(mx, s[q][i]);
    if (BR == 1) { m_use = m_fin; }
    else {
        mx = fmaxf(mx, __shfl_xor(mx, 32));
        if (mx < -1e29f) mx = -INFINITY;
        const float m_new = fmaxf(m, mx);
        grow = m_new > m;
        m_use = (m_new == -INFINITY) ? 0.f : m_new;
        alpha = __builtin_amdgcn_exp2f(m - m_use);
        m = m_new;
    }
    if (__builtin_amdgcn_ballot_w64((mx - m_use) > -150.f) == 0ull) {
        if (BR == 1) {
#pragma unroll
            for (int ti = 0; ti < NT; ++ti)
#pragma unroll
                for (int kt = 0; kt < 2; ++kt)
#pragma unroll
                    for (int v = 0; v < 4; ++v) { const int j = ti ? jB : jA; const float add = c.h ? 0.f : carry; carry = 0.f; if (c.r == 0) imp_row[16 * j + 8 * kt + 2 * v + c.h] = add; }
        }
        return;
    }
    f32x2_t sum2 = {0.f, 0.f}; const f32x2_t mm2 = {m_use, m_use}, il2 = {inv_l, inv_l};
#pragma unroll
    for (int q = 0; q < 2 * NT; ++q)
#pragma unroll
        for (int rr = 0; rr < 16; rr += 2) {
            const f32x2_t d = (f32x2_t){s[q][rr], s[q][rr + 1]} - mm2;
            f32x2_t p = (DV & 1) ? d : (f32x2_t){__builtin_amdgcn_exp2f(d.x), __builtin_amdgcn_exp2f(d.y)};
            if (BR == 1) p *= il2;
            s[q][rr] = p.x; s[q][rr + 1] = p.y; sum2 += p;
        }
    float sum = sum2.x + sum2.y;
    if (BR != 1) { sum += __shfl_xor(sum, 32); l = l * alpha + sum; }
    if (BR == 1) {
#pragma unroll
        for (int ti = 0; ti < NT; ++ti)
#pragma unroll
            for (int kt = 0; kt < 2; ++kt)
#pragma unroll
                for (int v = 0; v < 4; ++v) {
                    const int j = ti ? jB : jA;
                    float a = 2.f * (s[2 * ti + kt][4 * v] + s[2 * ti + kt][4 * v + 1] + s[2 * ti + kt][4 * v + 2]) + s[2 * ti + kt][4 * v + 3], bc = s[2 * ti + kt][4 * v + 3];
                    a += dpp_f<0xB1>(a); a += dpp_f<0x4E>(a); bc += dpp_f<0xB1>(bc); bc += dpp_f<0x4E>(bc);
                    const float bo = __shfl_xor(bc, 32);
                    const float add = a + (c.h ? bo : carry);
                    carry = bo;
                    if (c.r == 0) imp_row[16 * j + 8 * kt + 2 * v + c.h] = add;
                }
    }
    if (BR != 0) {
        if (BR != 1) {
            if (__builtin_amdgcn_ballot_w64(grow) != 0ull) {
#pragma unroll
                for (int i = 0; i < 16; ++i) { O[0][i] *= alpha; O[1][i] *= alpha; }
            }
        }
        if (!(DV & 2) && __builtin_amdgcn_ballot_w64(sum > 0.f) != 0ull) {
#pragma unroll
            for (int ti = 0; ti < NT; ++ti)
#pragma unroll
                for (int kt = 0; kt < 2; ++kt)
#pragma unroll
                    for (int u = 0; u < 2; ++u) {
                        LAS unsigned char* vb = ti ? vbB : vbA;
                        const f32x16& sv = s[2 * ti + kt];
                        u32x4 pw; pw.x = pk2(sv[8 * u], sv[8 * u + 1]); pw.y = pk2(sv[8 * u + 2], sv[8 * u + 3]); pw.z = pk2(sv[8 * u + 4], sv[8 * u + 5]); pw.w = pk2(sv[8 * u + 6], sv[8 * u + 7]);
                        const bf16x8 pf = __builtin_bit_cast(bf16x8, pw);
                        const int kbase = kt * 32 + 16 * u;
#pragma unroll
                        for (int mt = 0; mt < 2; ++mt) {
                            const LAS unsigned char* vp = vb + (mt * 32 + c.n) * 136 + (kbase + 4 * c.h) * 2;
                            const u32x2 lo = *(const LAS u32x2*)vp, hi = *(const LAS u32x2*)(vp + 16);
                            const bf16x8 af = __builtin_bit_cast(bf16x8, (u32x4){lo.x, lo.y, hi.x, hi.y});
                            O[mt] = MFMA32(af, pf, O[mt]);
                        }
                    }
        }
    }
}

constexpr int AT_PAIR = 35840, AT_K1 = 9216, AT_V0 = 18432, AT_V1 = 18432 + 8704;
template <int BR, int DV>
DI void attn_tiles(const int wv, LAS unsigned char* lds, const bf16* Kbase, size_t ldk, size_t ktile, const bf16* Vbase, size_t ldv, size_t vtile,
                   u64 mlo, u64 mhi, const ACtx& c, const int qb, float& m, float& l, f32x16 (&O)[2], float m_fin, float inv_l, LAS float* imp_row, float& carry) {
    constexpr bool DESC = (BR >= 2) || (BR == 0);
    const int tid = TIDX, srow = tid >> 3, sch = tid & 7;
#define AT_NEXT() (DESC ? m128_last(mlo, mhi) : m128_first(mlo, mhi))
#define AT_LOAD(RK, RV, JJ) do { RK = *(const u32x4*)(Kbase + (size_t)(JJ) * ktile + (size_t)srow * ldk + sch * 8); \
        if (BR != 0) RV = *(const u32x4*)(Vbase + (size_t)(JJ) * vtile + (size_t)srow * ldv + sch * 8); } while (0)
#define AT_WRITE(RK, RV, KOFF, VOFF) do { *(LAS u32x4*)(pb + (KOFF) + srow * 144 + sch * 16) = RK; \
        if (BR != 0) { *(LAS u32x2*)(pb + (VOFF) + srow * 136 + sch * 16) = (u32x2){RV.x, RV.y}; *(LAS u32x2*)(pb + (VOFF) + srow * 136 + sch * 16 + 8) = (u32x2){RV.z, RV.w}; } } while (0)
    int j0 = AT_NEXT();
    if (j0 < 0) return;
    m128_clear(mlo, mhi, j0);
    int j1 = AT_NEXT();
    if (j1 >= 0) m128_clear(mlo, mhi, j1);
    u32x4 rk0, rv0 = (u32x4){0u, 0u, 0u, 0u}, rk1 = (u32x4){0u, 0u, 0u, 0u}, rv1 = (u32x4){0u, 0u, 0u, 0u};
    AT_LOAD(rk0, rv0, j0);
    if (j1 >= 0) AT_LOAD(rk1, rv1, j1);
    int buf = 0;
    __syncthreads();
    while (j0 >= 0) {
        LAS unsigned char* pb = lds + buf * AT_PAIR;
        AT_WRITE(rk0, rv0, 0, AT_V0);
        if (j1 >= 0) AT_WRITE(rk1, rv1, AT_K1, AT_V1);
        int n0 = (j1 >= 0) ? AT_NEXT() : -1;
        if (n0 >= 0) m128_clear(mlo, mhi, n0);
        int n1 = (n0 >= 0) ? AT_NEXT() : -1;
        if (n1 >= 0) m128_clear(mlo, mhi, n1);
        if (n0 >= 0) AT_LOAD(rk0, rv0, n0);
        if (n1 >= 0) AT_LOAD(rk1, rv1, n1);
        __syncthreads();
        const bool act0 = (BR != 2) || m128_bit(c.wun_lo, c.wun_hi, j0);
        const bool act1 = (j1 >= 0) && ((BR != 2) || m128_bit(c.wun_lo, c.wun_hi, j1));
        if (act0 && act1) attn_compute<BR, 2, DV>(pb, pb + AT_V0, pb + AT_K1, pb + AT_V1, j0, j1, c, qb, m, l, O, m_fin, inv_l, imp_row, carry);
        else if (act0) attn_compute<BR, 1, DV>(pb, pb + AT_V0, pb, pb + AT_V0, j0, j0, c, qb, m, l, O, m_fin, inv_l, imp_row, carry);
        else if (act1) attn_compute<BR, 1, DV>(pb + AT_K1, pb + AT_V1, pb + AT_K1, pb + AT_V1, j1, j1, c, qb, m, l, O, m_fin, inv_l, imp_row, carry);
        j0 = n0; j1 = n1; buf ^= 1;
    }
#undef AT_NEXT
#undef AT_LOAD
#undef AT_WRITE
}

template <int DV>
DI void attn_unit(const int wv, const Args& A, LAS unsigned char* lds, int b, int g, int qb, int dry) {
    const int tid = TIDX, lane = tid & 63, wave = wv;
    unsigned char* ws = A.ws;
    ACtx c; c.h = lane >> 5; c.n = lane & 31; c.qi = c.n >> 2; c.r = c.n & 3; c.wave = wave; c.t = qb * 64 + wave * 8 + c.qi;
    const int head = g * 4 + c.r;
    c.slope2 = __builtin_amdgcn_exp2f(-0.5f * (float)(head + 1)) * LOG2E;
    { const unsigned shi = f2bf(c.slope2); const float slo = c.slope2 - bf2f(shi); c.slopew = shi | (f2bf(slo) << 16); c.slope16w = f2bf(16.f * bf2f(shi)) | (f2bf(16.f * slo) << 16);
#pragma unroll
      for (int kt = 0; kt < 2; ++kt) { const unsigned kk = f2bf((float)(kt * 32 + c.n)); u32x4 aw = (u32x4){kk | (kk << 16), 0x3F803F80u, 0u, 0u}; if (c.h) aw = (u32x4){0u, 0u, 0u, 0u}; c.akey[kt] = __builtin_bit_cast(bf16x8, aw); } }
    c.sel_lo = c.sel_hi = c.wun_lo = c.wun_hi = 0ull;
    const size_t tokrow = (size_t)b * SEQ + c.t;
    { const bf16* q = (const bf16*)(ws + WS_Q) + tokrow * DM + head * 64 + 8 * c.h;
#pragma unroll
      for (int ks = 0; ks < 4; ++ks) c.qf[ks] = *(const bf16x8*)(q + ks * 16); }
    LAS float* IMP = (LAS float*)(lds + 71680);
    LAS u64* SEL = (LAS u64*)(lds + 137216);
    LAS u64* WUN = (LAS u64*)(lds + 138240);
    LAS float* imp_row = IMP + (wave * 8 + c.qi) * 132;
    const bf16* gn = (const bf16*)(ws + WS_GNSA) + tokrow * 64 + head * 3;
    const float g0 = sigmoidf_(bf2f(gn[0])), g1 = sigmoidf_(bf2f(gn[1])), g2 = sigmoidf_(bf2f(gn[2]));
    f32x16 O[2];
#pragma unroll
    for (int i = 0; i < 16; ++i) { O[0][i] = 0.f; O[1][i] = 0.f; }
    LAS float* ypark = (LAS float*)(lds + 71680 + wave * 8192) + lane;
    float m, l, carry = 0.f;
    if (!(dry & 2)) {
    const int nT = (4 * qb + 2) / 64 + 1;
    const u64 cm = (nT >= 64) ? ~0ull : ((1ull << nT) - 1ull);
    const bf16* Kc = (const bf16*)(ws + WS_KCC) + (size_t)(g * 8 + b) * 512 * 64;
    const bf16* Vc = (const bf16*)(ws + WS_VCT) + (size_t)(g * 8 + b) * 512;
    m = -INFINITY; l = 0.f;
    attn_tiles<0, DV>(wv, lds, Kc, 64, 64 * 64, Vc, 16384, 64, cm, 0ull, c, qb, m, l, O, 0.f, 0.f, imp_row, carry);
    {
        const float m_fin = (m == -INFINITY) ? 0.f : m, inv_l = 1.f / fmaxf(l, 1e-30f);
#pragma unroll
        for (int i = 0; i < 16; ++i) { O[0][i] = 0.f; O[1][i] = 0.f; }
        carry = 0.f;
        attn_tiles<1, DV>(wv, lds, Kc, 64, 64 * 64, Vc, 16384, 64, cm, 0ull, c, qb, m, l, O, m_fin, inv_l, imp_row, carry);
    }
    }
    __syncthreads();
    if (!(dry & 4)) {
        const int qi2 = lane >> 3, l8 = lane & 7;
        const LAS float* irow = IMP + (wave * 8 + qi2) * 132;
        u64 slo = 0ull, shi = 0ull;
        if (qb + 1 <= 16) { slo = (1ull << (qb + 1)) - 1ull; }
        else {
            float sc[16]; unsigned selm = 0u;
#pragma unroll
            for (int i = 0; i < 16; ++i) { const int jj = l8 + 8 * i; const bool forced = (jj == 0 || jj == qb || jj == qb - 1);
                const bool cand = (jj <= qb) && !forced; sc[i] = cand ? irow[jj] : -1.f; if (forced) selm |= 1u << i; }
            for (int round = 0; round < 13; ++round) {
                float lm = sc[0];
#pragma unroll
                for (int i = 1; i < 16; ++i) lm = fmaxf(lm, sc[i]);
                lm = fmaxf(lm, dpp_f<0xB1>(lm)); lm = fmaxf(lm, dpp_f<0x4E>(lm)); lm = fmaxf(lm, dpp_f<0x141>(lm));
                int li = 99;
#pragma unroll
                for (int i = 15; i >= 0; --i) li = (sc[i] == lm) ? i : li;
                int cj = (li < 16) ? (l8 + 8 * li) : 999;
                cj = min(cj, dpp_i<0xB1>(cj)); cj = min(cj, dpp_i<0x4E>(cj)); cj = min(cj, dpp_i<0x141>(cj));
                const int tt = cj - l8;
#pragma unroll
                for (int i = 0; i < 16; ++i) { const bool hit = (tt == 8 * i); sc[i] = hit ? -1.f : sc[i]; selm |= hit ? (1u << i) : 0u; }
            }
#pragma unroll
            for (int i = 0; i < 16; ++i) { if ((selm >> i) & 1u) { if (i < 8) slo |= 1ull << (l8 + 8 * i); else shi |= 1ull << (l8 + 8 * (i - 8)); } }
        }
        unsigned w0 = (unsigned)slo, w1 = (unsigned)(slo >> 32), w2 = (unsigned)shi, w3 = (unsigned)(shi >> 32);
#pragma unroll
        for (int o = 1; o < 8; o <<= 1) { w0 |= __shfl_xor(w0, o); w1 |= __shfl_xor(w1, o); w2 |= __shfl_xor(w2, o); w3 |= __shfl_xor(w3, o); }
        if (l8 == 0) { SEL[(wave * 8 + qi2) * 2] = ((u64)w1 << 32) | w0; SEL[(wave * 8 + qi2) * 2 + 1] = ((u64)w3 << 32) | w2; }
#pragma unroll
        for (int o = 8; o < 64; o <<= 1) { w0 |= __shfl_xor(w0, o); w1 |= __shfl_xor(w1, o); w2 |= __shfl_xor(w2, o); w3 |= __shfl_xor(w3, o); }
        if (lane == 0) { WUN[wave * 2] = ((u64)w1 << 32) | w0; WUN[wave * 2 + 1] = ((u64)w3 << 32) | w2; }
        c.wun_lo = ((u64)w1 << 32) | w0; c.wun_hi = ((u64)w3 << 32) | w2;
    }
    __syncthreads();
    u64 bun_lo = 0ull, bun_hi = 0ull;
#pragma unroll
    for (int w = 0; w < 8; ++w) { bun_lo |= WUN[w * 2]; bun_hi |= WUN[w * 2 + 1]; }
    c.sel_lo = SEL[(wave * 8 + c.qi) * 2]; c.sel_hi = SEL[(wave * 8 + c.qi) * 2 + 1];
#pragma unroll
    for (int i = 0; i < 16; ++i) { ypark[i * 64] = g0 * O[0][i]; ypark[(16 + i) * 64] = g0 * O[1][i]; }
    if (!(dry & 8)) {
        const bf16* Ks = (const bf16*)(ws + WS_KSL) + (size_t)b * SEQ * 256 + g * 64;
        const bf16* Vs = (const bf16*)(ws + WS_VTSL) + (size_t)(g * 64) * MTOK + (size_t)b * SEQ;
        m = -INFINITY; l = 0.f;
#pragma unroll
        for (int i = 0; i < 16; ++i) { O[0][i] = 0.f; O[1][i] = 0.f; }
        attn_tiles<2, DV>(wv, lds, Ks, 256, 64 * 256, Vs, MTOK, 64, bun_lo, bun_hi, c, qb, m, l, O, 0.f, 0.f, imp_row, carry);
        const float sc = g1 / fmaxf(l, 1e-30f);
#pragma unroll
        for (int i = 0; i < 16; ++i) { ypark[i * 64] += sc * O[0][i]; ypark[(16 + i) * 64] += sc * O[1][i]; }
    }
    if (!(dry & 16)) {
        const bf16* Kw = (const bf16*)(ws + WS_KW) + (size_t)b * SEQ * 256 + g * 64;
        const bf16* Vw = (const bf16*)(ws + WS_VTW) + (size_t)(g * 64) * MTOK + (size_t)b * SEQ;
        const int jlo = qb >= 8 ? qb - 8 : 0;
        u64 wlo = 0ull, whi = 0ull;
        for (int jj = jlo; jj <= qb; ++jj) { if (jj < 64) wlo |= 1ull << jj; else whi |= 1ull << (jj - 64); }
        m = -INFINITY; l = 0.f;
#pragma unroll
        for (int i = 0; i < 16; ++i) { O[0][i] = 0.f; O[1][i] = 0.f; }
        attn_tiles<3, DV>(wv, lds, Kw, 256, 64 * 256, Vw, MTOK, 64, wlo, whi, c, qb, m, l, O, 0.f, 0.f, imp_row, carry);
        const float sc = g2 / fmaxf(l, 1e-30f);
#pragma unroll
        for (int i = 0; i < 16; ++i) { O[0][i] = ypark[i * 64] + sc * O[0][i]; O[1][i] = ypark[(16 + i) * 64] + sc * O[1][i]; }
    }
    if (!(dry & 32))
    {
        bf16* Yb = (bf16*)A.out; const bf16* GMA = (const bf16*)(ws + WS_GMA);
        u32x2 yrv[8], gmv[8], ctv[8]; f32x4 crv[8];
        const bf16* CTb = (const bf16*)(ws + WS_CT); const float* CRb = (const float*)(ws + WS_CARRY) + ((size_t)b * 64 + (c.t >> 7)) * DM + head * 64 + 4 * c.h;
#pragma unroll
        for (int k = 0; k < 8; ++k) {
            const int mt = k >> 2, v = k & 3;
            const size_t idx = tokrow * DM + head * 64 + mt * 32 + 8 * v + 4 * c.h;
            yrv[k] = *(const u32x2*)(Yb + idx); gmv[k] = *(const u32x2*)(GMA + idx); ctv[k] = *(const u32x2*)(CTb + idx); crv[k] = *(const f32x4*)(CRb + mt * 32 + 8 * v);
        }
#pragma unroll
        for (int k = 0; k < 8; ++k) {
            const int mt = k >> 2, v = k & 3;
            const size_t idx = tokrow * DM + head * 64 + mt * 32 + 8 * v + 4 * c.h;
            const u32x2 yr = yrv[k], gm = gmv[k], ct = ctv[k]; const f32x4 cr = crv[k];
            const float o0 = bflo(yr.x) + bflo(ct.x) * cr[0] + sigmoidf_(bflo(gm.x)) * O[mt][4 * v], o1 = bfhi(yr.x) + bfhi(ct.x) * cr[1] + sigmoidf_(bfhi(gm.x)) * O[mt][4 * v + 1];
            const float o2 = bflo(yr.y) + bflo(ct.y) * cr[2] + sigmoidf_(bflo(gm.y)) * O[mt][4 * v + 2], o3 = bfhi(yr.y) + bfhi(ct.y) * cr[3] + sigmoidf_(bfhi(gm.y)) * O[mt][4 * v + 3];
            *(u32x2*)(((dry & 1) ? (bf16*)(ws + 832 * MiB) : Yb) + idx) = (u32x2){pk2(o0, o1), pk2(o2, o3)};
        }
    }
}

template <bool NORM2>
DI void row_phase(const int wv, const bf16* RAW, const float* base, bf16* XB, bf16* NB, const float* g1, const float* g2, int G) {
    const int tid = TIDX, lane = tid & 63, wave = wv;
    const int gw = blockIdx.x * NWAVES + wave, NGW = G * NWAVES;
    constexpr int R = 4;
    for (int row0 = gw; row0 < MTOK; row0 += R * NGW) {
        float v[R][16], x[R][16];
#pragma unroll
        for (int r = 0; r < R; ++r) {
            const int row = (row0 + r * NGW < MTOK) ? row0 + r * NGW : row0;
#pragma unroll
            for (int jj = 0; jj < 2; ++jj) {
                const size_t off = (size_t)row * DM + 8 * lane + 512 * jj;
                const u32x4 rw = *(const u32x4*)(RAW + off);
                v[r][8 * jj + 0] = bflo(rw.x); v[r][8 * jj + 1] = bfhi(rw.x); v[r][8 * jj + 2] = bflo(rw.y); v[r][8 * jj + 3] = bfhi(rw.y);
                v[r][8 * jj + 4] = bflo(rw.z); v[r][8 * jj + 5] = bfhi(rw.z); v[r][8 * jj + 6] = bflo(rw.w); v[r][8 * jj + 7] = bfhi(rw.w);
                if (NORM2) {
                    const f32x4 x0 = *(const f32x4*)(base + off), x1 = *(const f32x4*)(base + off + 4);
                    x[r][8 * jj + 0] = x0[0]; x[r][8 * jj + 1] = x0[1]; x[r][8 * jj + 2] = x0[2]; x[r][8 * jj + 3] = x0[3]; x[r][8 * jj + 4] = x1[0]; x[r][8 * jj + 5] = x1[1]; x[r][8 * jj + 6] = x1[2]; x[r][8 * jj + 7] = x1[3];
                } else {
                    const u32x4 xw = *(const u32x4*)(XB + off);
                    x[r][8 * jj + 0] = bflo(xw.x); x[r][8 * jj + 1] = bfhi(xw.x); x[r][8 * jj + 2] = bflo(xw.y); x[r][8 * jj + 3] = bfhi(xw.y);
                    x[r][8 * jj + 4] = bflo(xw.z); x[r][8 * jj + 5] = bfhi(xw.z); x[r][8 * jj + 6] = bflo(xw.w); x[r][8 * jj + 7] = bfhi(xw.w);
                }
            }
        }
        float ga[16], gb[16];
#pragma unroll
        for (int jj = 0; jj < 2; ++jj)
#pragma unroll
            for (int i = 0; i < 8; ++i) { ga[8 * jj + i] = g1[8 * lane + 512 * jj + i]; gb[8 * jj + i] = NORM2 ? g2[8 * lane + 512 * jj + i] : 1.f; }
#pragma unroll
        for (int r = 0; r < R; ++r) {
            const int row = row0 + r * NGW;
            float ss = 0.f;
#pragma unroll
            for (int i = 0; i < 16; ++i) ss += v[r][i] * v[r][i];
            const float rs = rsqrtf(wave_sum(ss) * (1.f / DM) + NORM_EPS);
            float ss2 = 0.f;
#pragma unroll
            for (int i = 0; i < 16; ++i) { const float o = x[r][i] + v[r][i] * rs * ga[i]; x[r][i] = o; ss2 += o * o; }
            float rs2 = 1.f;
            if (NORM2) rs2 = rsqrtf(wave_sum(ss2) * (1.f / DM) + NORM_EPS);
            if (row < MTOK) {
#pragma unroll
                for (int jj = 0; jj < 2; ++jj) {
                    const size_t off = (size_t)row * DM + 8 * lane + 512 * jj;
                    const float* xx = &x[r][8 * jj];
                    const u32x4 xw = (u32x4){pk2(xx[0], xx[1]), pk2(xx[2], xx[3]), pk2(xx[4], xx[5]), pk2(xx[6], xx[7])};
                    if (NORM2) {
                        *(u32x4*)(XB + off) = xw;
                        float y[8];
#pragma unroll
                        for (int i = 0; i < 8; ++i) y[i] = xx[i] * rs2 * gb[8 * jj + i];
                        *(u32x4*)(NB + off) = (u32x4){pk2(y[0], y[1]), pk2(y[2], y[3]), pk2(y[4], y[5]), pk2(y[6], y[7])};
                    } else {
                        *(u32x4*)(NB + off) = xw;
                    }
                }
            }
        }
    }
}

__global__ void __launch_bounds__(NTHR, 2) hybrid_fwd(Args args) {
    extern __shared__ __attribute__((aligned(16))) unsigned char lds_raw[];
    LAS unsigned char* lds = (LAS unsigned char*)lds_raw;
    const int G = gridDim.x, bx = blockIdx.x;
    const int wv = __builtin_amdgcn_readfirstlane(threadIdx.x >> 6);
    unsigned char* ws = args.ws; unsigned char* dout = (unsigned char*)args.out;
    const int lo = args.ph_lo, hi = args.ph_hi;
#ifndef PHMASK
#define PHMASK 0xFFFF
#endif
#define IN(k) (((PHMASK >> (k)) & 1) && lo <= (k) && (k) < hi)
    volatile LAS unsigned* xst = (volatile LAS unsigned*)(lds + LDS_SLOT + 64);
    unsigned* xbar = (unsigned*)(ws + WS_BAR); unsigned xcc = 0u;
    if (hi - lo > 1) {
        if (wv == 0) { if (lane_id() == 0) { xst[0] = 0u; xst[1] = 0u;
            const __attribute__((address_space(4))) char* ia = (const __attribute__((address_space(4))) char*)__builtin_amdgcn_implicitarg_ptr();
            const unsigned long long p = *(const __attribute__((address_space(4))) unsigned long long*)(ia + 88);
            if (*(const unsigned*)(p + 40) != (unsigned)G) (void)xb_add(&xbar[XB_TMO], 0u); } }
        xcc = xb_xcc_id();
        if (wv == 0) { if (lane_id() == 0) (void)xb_add(&xbar[XB_XCNT(xcc)], 1u); }
        __syncthreads();
    }
#define SEAM(k) do { if (IN(k) && IN((k) + 1)) { xcd_barrier(wv, xbar, xcc, xst); } } while (0)
    using namespace pg8;

    for (int rep = 0; rep < (((PROBE_MASK >> 0) & 1) ? 2 : 1); ++rep) if (IN(0)) { p0_prologue(wv, args, lds, G); }
    SEAM(0);
    for (int rep = 0; rep < (((PROBE_MASK >> 1) & 1) ? 2 : 1); ++rep) if (IN(1)) {
        { GemmD g{(const char*)dout, (const char*)(ws + WS_WIN), DM, DM, DM, 128, 128, 0}; Sched S; S.init(256, 25, G, bx); EpiSec E{ws, dout};
          gemm_phase<EpiSec, true>(wv, lds, g, S, E); }
        { GemmD g{(const char*)(ws + WS_WV), (const char*)dout, DM, DM, DM, 128, 128, 0}; Sched S; S.init(2, 256, G, bx);
          EpiStore<0, 0> E{(bf16*)(ws + WS_VTSL), (size_t)MTOK, nullptr, 512, MTOK};
          gemm_phase<EpiStore<0, 0>, true>(wv, lds, g, S, E); }
    }
    SEAM(1);
    for (int rep = 0; rep < (((PROBE_MASK >> 2) & 1) ? 2 : 1); ++rep) if (IN(2)) {
        float* posbp = (float*)(ws + WS_POSBP) + (size_t)(bx & 255) * 512;
        { const int tid = TIDX; const int cv = (bx + G / 2) % G; const int mat = tid >> 8;
          if (mat == 0 ? (bx < 64) : (cv < 64)) { float t = 0.f; const float* part = (const float*)(ws + WS_PART) + tid;
              for (int it = 0; it < 256; ++it) t += part[it * 512];
              posbp[tid] = t; }
          asm volatile("s_waitcnt vmcnt(0)" ::: "memory"); __syncthreads(); }
        { GemmD g{(const char*)(ws + WS_KC), (const char*)(ws + WS_CW1K), 2048, 16 * 256, 2048, 512, 128, 1}; Sched S; S.init(64, 1, G, bx);
          EpiStore<1, 0> E{(bf16*)(ws + WS_HIDK), 256, posbp, 16384, 256};
          gemm_phase<EpiStore<1, 0>, false>(wv, lds, g, S, E); }
        { GemmD g{(const char*)(ws + WS_VC), (const char*)(ws + WS_CW1V), 2048, 16 * 256, 2048, 512, 128, 1}; Sched S; S.init(64, 1, G, (bx + G / 2) % G);
          EpiStore<1, 0> E{(bf16*)(ws + WS_HIDV), 256, posbp + 256, 16384, 256};
          gemm_phase<EpiStore<1, 0>, false>(wv, lds, g, S, E); }
        { GemmD g{(const char*)(ws + WS_HIDK), (const char*)(ws + WS_CW2K), 256, 256, 256, 128, 128, 0}; Sched S; S.init(64, 1, G, bx);
          EpiStore<0, 1> E{(bf16*)(ws + WS_KCC), 64, nullptr, 16384, 64};
          gemm_phase<EpiStore<0, 1>, false>(wv, lds, g, S, E); }
        { GemmD g{(const char*)(ws + WS_CW2V), (const char*)(ws + WS_HIDV), 256, 256, 256, 128, 128, 0}; Sched S; S.init(1, 64, G, (bx + G / 2) % G);
          EpiStore<0, 2> E{(bf16*)(ws + WS_VCT), 16384, nullptr, 64, 16384};
          gemm_phase<EpiStore<0, 2>, false>(wv, lds, g, S, E); }
        __syncthreads();
        for (;;) { const int it = next_item(wv, lds, (unsigned*)(ws + WS_CTR) + 64 * rep); if (it >= 1024) break; scan_item<2>(wv, args, lds, it); }
    }
    SEAM(2);
    for (int rep = 0; rep < (((PROBE_MASK >> 3) & 1) ? 2 : 1); ++rep) if (IN(3)) {
        __syncthreads();
        {
            const int gt = bx * NTHR + TIDX;
            if (gt < NB * DM) { const int b = gt >> 10, ch = gt & 1023; const float2* AG = (const float2*)(ws + WS_AGG2) + (size_t)b * 64 * DM + ch; float* CR = (float*)(ws + WS_CARRY) + (size_t)b * 64 * DM + ch;
                float hc = 0.f;
                for (int i = 0; i < 64; ++i) { CR[(size_t)i * DM] = hc; const float2 ag = AG[(size_t)i * DM]; hc = ag.x * hc + ag.y; } }
        }
    }
    SEAM(3);
    if (IN(4)) {
        if (wv >= 4) __builtin_amdgcn_s_setprio(1);
#if (PROBE_MASK >> 4) & 1
        for (int it = bx; it < 4096; it += G) { const int qb = 127 - (it >> 5), bg = it & 31; attn_unit<DRYV>(wv, args, lds, bg >> 2, bg & 3, qb, DRYMODE); }
#endif
        {
            const unsigned myx = xb_xcc_id() & 7u;
            for (unsigned dx = 0; dx < 8; ++dx) {
                const unsigned qx = (myx + dx) & 7u;
                unsigned* qctr = (unsigned*)(ws + WS_CTR) + 256 + 16 * qx;
                for (;;) {
                    const int it = next_item(wv, lds, qctr); if (it >= 512) break;
                    const int qb = 127 - (it >> 2), g = it & 3, b = (int)((qx + (unsigned)g) & 7u);
                    attn_unit<0>(wv, args, lds, b, g, qb, 0);
                }
            }
        }
        __builtin_amdgcn_s_setprio(0);
        __syncthreads();
    }
    SEAM(4);
    for (int rep = 0; rep < (((PROBE_MASK >> 5) & 1) ? 2 : 1); ++rep) if (IN(5)) {
        GemmD g{(const char*)dout, (const char*)(ws + WS_WOUT), DM, DM, DM, 128, 128, 0}; Sched S; S.init(256, 4, G, bx);
        EpiStore<0, 0> E{(bf16*)(ws + WS_RAW), DM, nullptr, MTOK, DM};
        gemm_phase<EpiStore<0, 0>, true>(wv, lds, g, S, E);
    }
    SEAM(5);
    for (int rep = 0; rep < (((PROBE_MASK >> 6) & 1) ? 2 : 1); ++rep) if (IN(6)) {
        row_phase<true>(wv, (const bf16*)(ws + WS_RAW), args.in[0], (bf16*)args.out, (bf16*)(ws + WS_H2), args.in[3], args.in[19], G);
        const float* p = args.in[1]; bf16* pb = (bf16*)(ws + WS_PB);
        for (size_t i = ((size_t)bx * NTHR + TIDX) * 8; i < (size_t)MTOK * DPLE; i += (size_t)G * NTHR * 8) {
            const f32x4 a = *(const f32x4*)(p + i), b2 = *(const f32x4*)(p + i + 4);
            *(u32x4*)(pb + i) = (u32x4){pk2(a[0], a[1]), pk2(a[2], a[3]), pk2(b2[0], b2[1]), pk2(b2[2], b2[3])};
        }
    }
    SEAM(6);
    for (int rep = 0; rep < (((PROBE_MASK >> 7) & 1) ? 2 : 1); ++rep) if (IN(7)) {
        { GemmD g{(const char*)(ws + WS_H2), (const char*)(ws + WS_WGU), DM, DM, DM, 128, 128, 0}; Sched S; S.init(256, 22, G, bx); EpiSwi E{(bf16*)(ws + WS_ACT)};
          gemm_phase<EpiSwi, true>(wv, lds, g, S, E); }
        { GemmD g{(const char*)(ws + WS_PB), (const char*)(ws + WS_WPP), DPLE, DPLE, DPLE, 128, 128, 0}; Sched S; S.init(256, 4, G, bx);
          EpiStore<0, 0> E{(bf16*)(ws + WS_PP), DM, nullptr, MTOK, DM};
          gemm_phase<EpiStore<0, 0>, true>(wv, lds, g, S, E); }
    }
    SEAM(7);
    for (int rep = 0; rep < (((PROBE_MASK >> 8) & 1) ? 2 : 1); ++rep) if (IN(8)) {
        GemmD g{(const char*)(ws + WS_ACT), (const char*)(ws + WS_WDN), DFF, DFF, DFF, 128, 128, 0}; Sched S; S.init(256, 4, G, bx);
        EpiStore<0, 0> E{(bf16*)(ws + WS_RAW), DM, nullptr, MTOK, DM};
        gemm_phase<EpiStore<0, 0>, true>(wv, lds, g, S, E);
    }
    SEAM(8);
    if (IN(9)) {
        row_phase<false>(wv, (const bf16*)(ws + WS_RAW), nullptr, (bf16*)args.out, (bf16*)(ws + WS_H2), args.in[20], nullptr, G);
    }
    SEAM(9);
    if (IN(10)) {
        GemmD g{(const char*)(ws + WS_H2), (const char*)(ws + WS_WPG), DM, DM, DM, 128, 128, 0}; Sched S; S.init(256, 4, G, bx);
        EpiPle E{args.out, (const bf16*)(ws + WS_H2), (const bf16*)(ws + WS_PP), args.in[25]};
        gemm_phase<EpiPle, true>(wv, lds, g, S, E);
    }
#undef IN
#undef SEAM
}

constexpr int NPHASE = 11;
#ifndef ONE_LAUNCH
#define ONE_LAUNCH 1
#endif

extern "C" void kernel_launch(void* const* d_in, const int* in_sizes, int n_in, void* d_out, int out_size, void* d_ws, size_t ws_size, hipStream_t stream) {
    static int grid = 0;
    if (grid == 0) {
        if (n_in != 26 || out_size != MTOK * DM || ws_size < WS_END) { fprintf(stderr, "kernel_launch: unexpected problem shape (n_in %d out %d ws %zu)\n", n_in, out_size, ws_size); grid = -1; return; }
        int dev = 0, cus = 0, per_cu = 0;
        hipGetDevice(&dev); hipDeviceGetAttribute(&cus, hipDeviceAttributeMultiprocessorCount, dev);
        hipFuncSetAttribute((const void*)hybrid_fwd, hipFuncAttributeMaxDynamicSharedMemorySize, LDS_BYTES);
        if (hipOccupancyMaxActiveBlocksPerMultiprocessor(&per_cu, (const void*)hybrid_fwd, NTHR, LDS_BYTES) != hipSuccess || per_cu < 1) per_cu = 1;
        (void)hipGetLastError();
        grid = cus * 1;
    }
    if (grid <= 0) return;
    Args a{};
    for (int i = 0; i < 26; ++i) a.in[i] = (const float*)d_in[i];
    a.out = (float*)d_out; a.ws = (unsigned char*)d_ws;
    (void)hipMemsetAsync((unsigned char*)d_ws + WS_CTR, 0, CTL_BYTES, stream);
#if ONE_LAUNCH
    a.ph_lo = 0; a.ph_hi = NPHASE;
    void* kargs[] = {&a};
    hipError_t e = hipLaunchCooperativeKernel((const void*)hybrid_fwd, dim3(grid), dim3(NTHR), kargs, LDS_BYTES, stream);
    if (e != hipSuccess) fprintf(stderr, "cooperative launch failed: %s (grid %d)\n", hipGetErrorString(e), grid);
#else
    for (int ph = 0; ph < NPHASE; ++ph) { a.ph_lo = ph; a.ph_hi = ph + 1; hipLaunchKernelGGL(hybrid_fwd, dim3(grid), dim3(NTHR), LDS_BYTES, stream, a); }
#endif
}
```

```cpp
#include <hip/hip_runtime.h>
#include <hip/hip_cooperative_groups.h>
#include <cstdio>
#include <cstdint>
namespace cg = cooperative_groups;
#ifndef DRYV
#define DRYV 0
#endif
#ifndef DRYMODE
#define DRYMODE 1
#endif
#ifndef PROBE_MASK
#define PROBE_MASK 0x0
#endif

#define LAS __attribute__((address_space(3)))
#define DI __device__ __forceinline__
typedef unsigned short bf16;
typedef short bf16x8 __attribute__((ext_vector_type(8)));
typedef short s16x4 __attribute__((ext_vector_type(4)));
typedef float f32x4 __attribute__((ext_vector_type(4)));
typedef float f32x16 __attribute__((ext_vector_type(16)));
typedef unsigned u32x4 __attribute__((ext_vector_type(4)));
typedef unsigned u32x2 __attribute__((ext_vector_type(2)));
typedef unsigned long long u64;

constexpr int NB = 8, SEQ = 8192, DM = 1024, MTOK = NB * SEQ, DFF = 2816, DPLE = 256, DIN = 6704;
constexpr int NWAVES = 8, NTHR = 512;
constexpr float NORM_EPS = 1e-6f;
constexpr float LOG2E = 1.4426950408889634f;

constexpr size_t MiB = (size_t)1 << 20, KiB = 1024;
constexpr size_t WS_WIN = 0;
constexpr size_t WS_WV = WS_WIN + (size_t)6400 * 2048;
constexpr size_t WS_WOUT = 14 * MiB, WS_WGU = 16 * MiB, WS_WDN = 27 * MiB, WS_WPG = 33 * MiB, WS_WPP = 35 * MiB;
constexpr size_t WS_CW1K = 36 * MiB, WS_CW1V = 37 * MiB, WS_CW2K = 38 * MiB, WS_CW2V = 38 * MiB + 128 * KiB;
constexpr size_t WS_LWA = 38 * MiB + 256 * KiB, WS_LWX = 38 * MiB + 384 * KiB, WS_POSB = 38 * MiB + 512 * KiB;
constexpr size_t WS_PART = 63 * MiB, WS_POSBP = 63 * MiB + 512 * KiB;
constexpr size_t WS_CTR = 38 * MiB + 768 * KiB, WS_BAR = WS_CTR + 16 * KiB, CTL_BYTES = 32 * KiB;
constexpr size_t WS_AGG = 39 * MiB;
constexpr size_t WS_HIDK = 43 * MiB, WS_HIDV = 51 * MiB;
constexpr size_t WS_KCC = 59 * MiB, WS_VCT = 61 * MiB;
constexpr size_t WS_XR = 64 * MiB, WS_GR = 192 * MiB, WS_Q = 320 * MiB, WS_KC = 448 * MiB, WS_VC = 480 * MiB, WS_KSL = 512 * MiB, WS_KW = 544 * MiB;
constexpr size_t WS_GMA = 576 * MiB, WS_GNSA = 704 * MiB, WS_VTSL = 712 * MiB, WS_VTW = 744 * MiB;
constexpr size_t WS_RAW = 64 * MiB, WS_H2 = 192 * MiB, WS_ACT = 320 * MiB, WS_PB = 672 * MiB, WS_PP = 704 * MiB;
constexpr size_t WS_CT = 832 * MiB;
constexpr size_t WS_CARRY = 39 * MiB;
constexpr size_t WS_AGG2 = 960 * MiB;
constexpr size_t WS_END = 964 * MiB;

constexpr int LDS_BYTES = 163840;

typedef __bf16 bf16x2_t __attribute__((ext_vector_type(2)));
typedef float f32x2_t __attribute__((ext_vector_type(2)));
DI unsigned pk2(float lo, float hi) { const f32x2_t v = {lo, hi}; const bf16x2_t b = __builtin_convertvector(v, bf16x2_t); return __builtin_bit_cast(unsigned, b); }
DI unsigned f2bf(float f) { return pk2(f, 0.f) & 0xffffu; }
DI float bf2f(unsigned b) { return __builtin_bit_cast(float, b << 16); }
DI float bflo(unsigned w) { return __builtin_bit_cast(float, w << 16); }
DI float bfhi(unsigned w) { return __builtin_bit_cast(float, w & 0xffff0000u); }
DI float sigmoidf_(float x) { return __builtin_amdgcn_rcpf(1.f + __builtin_amdgcn_exp2f(fminf(-x * LOG2E, 126.f))); }
DI float gelu_tanh(float x) { const float u = 0.7978845608028654f * (x + 0.044715f * x * x * x); return x * sigmoidf_(2.f * u); }
template <int CTRL> DI float dpp_f(float x) { return __builtin_bit_cast(float, __builtin_amdgcn_update_dpp(0, __builtin_bit_cast(int, x), CTRL, 0xF, 0xF, true)); }
template <int CTRL> DI int dpp_i(int x) { return __builtin_amdgcn_update_dpp(0, x, CTRL, 0xF, 0xF, true); }
DI float wave_sum(float v) {
#pragma unroll
    for (int o = 1; o < 64; o <<= 1) v += __shfl_xor(v, o);
    return v;
}
DI int lane_id() { int l; asm volatile("v_mbcnt_lo_u32_b32 %0, -1, 0\n\tv_mbcnt_hi_u32_b32 %0, -1, %0" : "=v"(l)); return l; }
#define TIDX (wv * 64 + lane_id())
DI void grid_sync_(const int wv) {
    __builtin_amdgcn_fence(__ATOMIC_RELEASE, "workgroup");
    __builtin_amdgcn_s_barrier();
    if (wv == 0) {
        if (lane_id() == 0) {
            __builtin_amdgcn_fence(__ATOMIC_ACQUIRE, "workgroup");
            __builtin_amdgcn_fence(__ATOMIC_RELEASE, "agent");
            const __attribute__((address_space(4))) char* ia = (const __attribute__((address_space(4))) char*)__builtin_amdgcn_implicitarg_ptr();
            const unsigned long long p = *(const __attribute__((address_space(4))) unsigned long long*)(ia + 88);
            unsigned* cnt = (unsigned*)(p + 32);
            const unsigned n = *(const unsigned*)(p + 40);
            const unsigned v = __hip_atomic_fetch_add(cnt, 1u, __ATOMIC_RELAXED, __HIP_MEMORY_SCOPE_AGENT);
            if ((v & 0xffffu) == n - 1u) (void)__hip_atomic_fetch_add(cnt, 65536u - n, __ATOMIC_RELAXED, __HIP_MEMORY_SCOPE_AGENT);
            const unsigned gen = v & 0xffff0000u;
            while ((__hip_atomic_load(cnt, __ATOMIC_RELAXED, __HIP_MEMORY_SCOPE_AGENT) & 0xffff0000u) == gen) __builtin_amdgcn_s_sleep(1);
            __builtin_amdgcn_fence(__ATOMIC_ACQUIRE, "agent");
            __builtin_amdgcn_fence(__ATOMIC_RELEASE, "workgroup");
        }
    }
    __builtin_amdgcn_s_barrier();
    __builtin_amdgcn_fence(__ATOMIC_ACQUIRE, "workgroup");
}
constexpr int LDS_SLOT = 155648;
DI int next_item(const int wv, LAS unsigned char* lds, unsigned* ctr) {
    __syncthreads();
    if (wv == 0) { if (lane_id() == 0) *(volatile LAS int*)(lds + LDS_SLOT) = (int)__hip_atomic_fetch_add(ctr, 1u, __ATOMIC_RELAXED, __HIP_MEMORY_SCOPE_AGENT); }
    __syncthreads();
    return *(volatile LAS int*)(lds + LDS_SLOT);
}

#define XB_TMO      128
#define XB_XCNT(j)  (256  + 64 * (j))
#define XB_XSUB(j)  (1280 + 64 * (j))
#define XB_XGEN(j)  (2304 + 64 * (j))
#define XB_TOP      3328
#define XB_TOPGEN   3392
#define XCD_BAR_WORDS 3456
#define XB_SPIN_CAP (1u << 22)
DI unsigned xb_ld(unsigned* p)              { return __hip_atomic_load(p, __ATOMIC_RELAXED, __HIP_MEMORY_SCOPE_AGENT); }
DI unsigned xb_add(unsigned* p, unsigned v) { return __hip_atomic_fetch_add(p, v, __ATOMIC_RELAXED, __HIP_MEMORY_SCOPE_AGENT); }
DI unsigned xb_xcc_id() { return (unsigned)__builtin_amdgcn_s_getreg((3 << 11) | 20) & 0xFu; }
#define XB_SPIN(cond, bar) do { unsigned _sp = 0; while (cond) { __builtin_amdgcn_s_sleep(1); \
    if ((++_sp & 255u) == 0u) { if (xb_ld(&(bar)[XB_TMO])) break; if (_sp > XB_SPIN_CAP) { atomicAdd(&(bar)[XB_TMO], 1u); break; } } } } while (0)
DI void xcd_barrier_complete(unsigned* bar, unsigned x, unsigned& nloc, unsigned& nx) {
    const unsigned G = gridDim.x * gridDim.y * gridDim.z;
    unsigned sum, cnt, mine, sp = 0u;
    for (;;) {
        sum = 0u; cnt = 0u; mine = 0u;
#pragma unroll
        for (unsigned j = 0; j < 16; ++j) { const unsigned c = xb_ld(&bar[XB_XCNT(j)]); sum += c; cnt += (c > 0u) ? 1u : 0u; mine = (j == x) ? c : mine; }
        if (sum == G) break;
        __builtin_amdgcn_s_sleep(1);
        if ((++sp & 255u) == 0u) { if (xb_ld(&bar[XB_TMO])) break; if (sp > XB_SPIN_CAP) { atomicAdd(&bar[XB_TMO], 1u); break; } }
    }
    nloc = mine > 0u ? mine : 1u; nx = cnt > 0u ? cnt : 1u;
}
DI void xcd_barrier(const int wv, unsigned* bar, const unsigned x, volatile LAS unsigned* st) {
    asm volatile("s_waitcnt vmcnt(0)" ::: "memory");
    __syncthreads();
    if (wv == 0) { if (lane_id() == 0) {
        __builtin_amdgcn_s_waitcnt(0);
        unsigned nloc = st[0], nx = st[1];
        if (nloc == 0u) { xcd_barrier_complete(bar, x, nloc, nx); st[0] = nloc; st[1] = nx; }
        const unsigned old = xb_add(&bar[XB_XSUB(x)], 1u);
        const unsigned gen = old / nloc;
        if (old + 1u == (gen + 1u) * nloc) {
            __builtin_amdgcn_fence(__ATOMIC_RELEASE, "agent");
            asm volatile("s_waitcnt vmcnt(0)" ::: "memory");
            const unsigned og = xb_add(&bar[XB_TOP], 1u);
            const unsigned tg = og / nx;
            if (og + 1u == (tg + 1u) * nx) xb_add(&bar[XB_TOPGEN], 1u);
            else XB_SPIN(xb_ld(&bar[XB_TOPGEN]) == tg, bar);
            __builtin_amdgcn_fence(__ATOMIC_ACQUIRE, "agent");
            xb_add(&bar[XB_XGEN(x)], 1u);
            asm volatile("s_waitcnt vmcnt(0)" ::: "memory");
        } else {
            XB_SPIN(xb_ld(&bar[XB_XGEN(x)]) == gen, bar);
            __builtin_amdgcn_fence(__ATOMIC_ACQUIRE, "agent");
            asm volatile("s_waitcnt vmcnt(0)" ::: "memory");
        }
    } }
    __syncthreads();
}
#define LDS_WAIT() asm volatile("s_waitcnt lgkmcnt(0)" ::: "memory")

namespace pg8 {
constexpr int BM = 256, BK = 64, HALF = 128, HTB = HALF * BK * 2, NXCD = 8, WGM = 8;
DI int lds_byte(int r, int c) { const int st = (r >> 4) * 2 + (c >> 5), rr = r & 15, cc = c & 31, ob = rr * 64 + cc * 2; return st * 1024 + (ob ^ (((ob >> 9) & 1) << 5)); }
DI void stage_rc(int b, int& R, int& C) { const int st = b / 1024, sb = b % 1024, swz = sb ^ (((sb >> 9) & 1) << 5); R = (st >> 1) * 16 + swz / 64; C = (st & 1) * 32 + (swz % 64) / 2; }
DI int perm32(int rho) { const int n = rho >> 4, i = rho & 15; return 8 * (i >> 2) + 4 * n + (i & 3); }
struct Unit { int pm, pn; };
struct Sched {
    int nM, nN, nwg, G, c;
    DI void init(int nM_, int nN_, int G_, int c_) { nM = nM_; nN = nN_; nwg = nM * nN; G = G_; c = c_; }
    DI bool next(int i, Unit& u) const {
        const long L = (long)i * G + c; if (L >= nwg) return false;
        int wgid = (int)L; { const int q = nwg / NXCD, r = nwg % NXCD, xcd = wgid % NXCD, off = wgid / NXCD; wgid = (xcd < r ? xcd * (q + 1) : r * (q + 1) + (xcd - r) * q) + off; }
        const int nig = WGM * nN, gid = wgid / nig, fm = gid * WGM, gsz = (nM - fm) < WGM ? (nM - fm) : WGM;
        u.pm = fm + ((wgid % nig) % gsz); u.pn = (wgid % nig) / gsz; return true;
    }
};
struct GemmD {
    const char* A; const char* Bt; int K; unsigned lda, ldb, kstepA, kstepB; int amode;
    DI const char* a(const Unit& u) const {
        if (amode == 1) return A + (((size_t)(u.pm & 15) * 256 * 16 * 256) + (size_t)(u.pm >> 4) * 64) * 2;
        return A + (size_t)u.pm * 256 * lda * 2;
    }
    DI const char* b(const Unit& u) const { return Bt + (size_t)u.pn * 256 * ldb * 2; }
};

template <class Epi, bool ALIGN_EPI>
DI void gemm_phase(const int wv, LAS unsigned char* lds, const GemmD g, const Sched& S, const Epi& E) {
    const int tid = TIDX, wid = wv, lane = tid & 63, wr = wid >> 2, wc = wid & 3, fr = lane & 15, fq = lane >> 4;
    const int nt = g.K / BK;
    unsigned voffA[2], voffB[2];
#pragma unroll
    for (int i = 0; i < 2; ++i) { int R, C; stage_rc(tid * 16 + i * 8192, R, C); const int Rb = (R & ~31) + perm32(R & 31);
        voffA[i] = (unsigned)(R * g.lda + C) * 2u; voffB[i] = (unsigned)(Rb * g.ldb + C) * 2u; }
    const size_t kstepA = g.kstepA, kstepB = g.kstepB;
    const size_t hstepA = (size_t)HALF * g.lda * 2, hstepB = (size_t)HALF * g.ldb * 2;
    const unsigned ldsw = (unsigned)wid * 1024u;
    const int aoff = lds_byte(wr * 64 + fr, fq * 8), boff = lds_byte(wc * 32 + fr, fq * 8);
#define PG8_SA(b, h) (((b) * 2 + (h)) * HTB)
#define PG8_SB(b, h) ((4 + (b) * 2 + (h)) * HTB)
#define PG8_STAGE(bufoff, gbase, voff) do { _Pragma("unroll") for (int _i = 0; _i < 2; ++_i) \
        __builtin_amdgcn_global_load_lds((const unsigned*)((const char*)(gbase) + (voff)[_i]), (LAS unsigned*)(lds + (bufoff) + ldsw + _i * 8192), 16, 0, 0); } while (0)
#define PG8_LDA(dst, b, h) do { _Pragma("unroll") for (int m = 0; m < 4; ++m) _Pragma("unroll") for (int k = 0; k < 2; ++k) dst[m][k] = *(const LAS bf16x8*)(lds + PG8_SA(b, h) + aoff + m * 2048 + k * 1024); } while (0)
#define PG8_LDB(dst, b, h) do { _Pragma("unroll") for (int n = 0; n < 2; ++n) _Pragma("unroll") for (int k = 0; k < 2; ++k) dst[n][k] = *(const LAS bf16x8*)(lds + PG8_SB(b, h) + boff + n * 2048 + k * 1024); } while (0)
#define PG8_MMA(ai, bj, At, Bt) do { __builtin_amdgcn_s_setprio(1); _Pragma("unroll") for (int m = 0; m < 4; ++m) _Pragma("unroll") for (int n = 0; n < 2; ++n) _Pragma("unroll") for (int k = 0; k < 2; ++k) \
        acc[ai][bj][m][n] = __builtin_amdgcn_mfma_f32_16x16x32_bf16(Bt[n][k], At[m][k], acc[ai][bj][m][n], 0, 0, 0); __builtin_amdgcn_s_setprio(0); } while (0)
#define PG8_WAIT_V(n) asm volatile("s_waitcnt vmcnt(" #n ")" ::: "memory")
#define PG8_WAIT_L(n) asm volatile("s_waitcnt lgkmcnt(" #n ")" ::: "memory")
#define PG8_BAR __builtin_amdgcn_s_barrier()
#define PG8_SCHED __builtin_amdgcn_sched_barrier(0)
    Unit cur, nxt; int ui = 0;
    if (!S.next(0, cur)) return;
    f32x4 acc[2][2][4][2];
#pragma unroll
    for (int a = 0; a < 2; ++a)
#pragma unroll
        for (int b = 0; b < 2; ++b)
#pragma unroll
            for (int m = 0; m < 4; ++m)
#pragma unroll
                for (int n = 0; n < 2; ++n) acc[a][b][m][n] = (f32x4){0.f, 0.f, 0.f, 0.f};
    bf16x8 At[4][2], B0[2][2], B1[2][2];
    const char* cA = g.a(cur); const char* cB = g.b(cur);
    PG8_STAGE(PG8_SB(0, 0), cB, voffB); PG8_STAGE(PG8_SB(0, 1), cB + hstepB, voffB); PG8_STAGE(PG8_SA(0, 0), cA, voffA); PG8_STAGE(PG8_SA(0, 1), cA + hstepA, voffA);
    if (wr == 1) PG8_BAR;
    PG8_WAIT_V(2); PG8_BAR;
    PG8_STAGE(PG8_SB(1, 0), cB + kstepB, voffB); PG8_STAGE(PG8_SA(1, 0), cA + kstepA, voffA); PG8_STAGE(PG8_SB(1, 1), cB + hstepB + kstepB, voffB);
    PG8_WAIT_V(6); PG8_BAR;
    for (;;) {
        const bool has_next = S.next(ui + 1, nxt);
        const char* nA = has_next ? g.a(nxt) : cA; const char* nB = has_next ? g.b(nxt) : cB;
        for (int t = 0; t < nt; t += 2) {
            const bool last = (t == nt - 2);
            const char* a1 = cA + (size_t)(t + 1) * kstepA;
            const char* a2 = last ? nA : cA + (size_t)(t + 2) * kstepA; const char* b2 = last ? nB : cB + (size_t)(t + 2) * kstepB;
            const char* a3 = a2 + kstepA; const char* b3 = b2 + kstepB;
            PG8_LDB(B0, 0, 0); PG8_LDB(B1, 0, 1); PG8_SCHED; PG8_LDA(At, 0, 0); PG8_STAGE(PG8_SA(1, 1), a1 + hstepA, voffA);
            PG8_WAIT_V(8); PG8_WAIT_L(0); PG8_BAR; PG8_MMA(0, 0, At, B0); PG8_MMA(0, 1, At, B1); PG8_BAR; PG8_SCHED;
            PG8_LDA(At, 0, 1); PG8_STAGE(PG8_SB(0, 0), b2, voffB); PG8_STAGE(PG8_SB(0, 1), b2 + hstepB, voffB); PG8_STAGE(PG8_SA(0, 0), a2, voffA);
            PG8_WAIT_V(8); PG8_WAIT_L(0); PG8_BAR; PG8_MMA(1, 0, At, B0); PG8_MMA(1, 1, At, B1); PG8_BAR; PG8_SCHED;
            PG8_LDB(B0, 1, 0); PG8_LDB(B1, 1, 1); PG8_SCHED; PG8_LDA(At, 1, 0); PG8_STAGE(PG8_SA(0, 1), a2 + hstepA, voffA);
            PG8_WAIT_V(8); PG8_WAIT_L(0); PG8_BAR; PG8_MMA(0, 0, At, B0); PG8_MMA(0, 1, At, B1); PG8_BAR; PG8_SCHED;
            PG8_LDA(At, 1, 1); PG8_STAGE(PG8_SB(1, 0), b3, voffB); PG8_STAGE(PG8_SB(1, 1), b3 + hstepB, voffB); PG8_STAGE(PG8_SA(1, 0), a3, voffA);
            PG8_WAIT_V(8); PG8_WAIT_L(0); PG8_BAR; PG8_MMA(1, 0, At, B0); PG8_MMA(1, 1, At, B1); PG8_BAR; PG8_SCHED;
        }
        if constexpr (ALIGN_EPI) { if (wr == 0) PG8_BAR; }
        E(acc, cur, wr, wc, fr, fq);
        if (!has_next) break;
#pragma unroll
        for (int a = 0; a < 2; ++a)
#pragma unroll
            for (int b = 0; b < 2; ++b)
#pragma unroll
                for (int m = 0; m < 4; ++m)
#pragma unroll
                    for (int n = 0; n < 2; ++n) acc[a][b][m][n] = (f32x4){0.f, 0.f, 0.f, 0.f};
        cur = nxt; cA = nA; cB = nB; ++ui;
        if constexpr (ALIGN_EPI) { if (wr == 1) PG8_BAR; }
    }
    PG8_WAIT_V(0);
    if constexpr (!ALIGN_EPI) { if (wr == 0) PG8_BAR; }
    PG8_BAR;
#undef PG8_SA
#undef PG8_SB
#undef PG8_STAGE
#undef PG8_LDA
#undef PG8_LDB
#undef PG8_MMA
#undef PG8_WAIT_V
#undef PG8_WAIT_L
#undef PG8_BAR
#undef PG8_SCHED
}

#define EPI_LOOP for (int ai = 0; ai < 2; ++ai) _Pragma("unroll") for (int m = 0; m < 4; ++m) _Pragma("unroll") for (int bj = 0; bj < 2; ++bj)
DI u32x4 pack8(const f32x4 v0, const f32x4 v1) { u32x4 w; w.x = pk2(v0[0], v0[1]); w.y = pk2(v0[2], v0[3]); w.z = pk2(v1[0], v1[1]); w.w = pk2(v1[2], v1[3]); return w; }

template <int ACT, int ZM> struct EpiStore {
    bf16* O; size_t ld; const float* bias; int row_valid, col_valid;
    DI void operator()(const f32x4 (&acc)[2][2][4][2], const Unit& u, int wr, int wc, int fr, int fq) const {
#pragma unroll
        EPI_LOOP {
            const int row = u.pm * 256 + ai * 128 + wr * 64 + m * 16 + fr, col0 = u.pn * 256 + bj * 128 + wc * 32 + 8 * fq;
            if (row < row_valid && col0 < col_valid) {
                f32x4 v0 = acc[ai][bj][m][0], v1 = acc[ai][bj][m][1];
                if (bias) { v0 += *(const f32x4*)(bias + col0); v1 += *(const f32x4*)(bias + col0 + 4); }
                if (ACT == 1) {
#pragma unroll
                    for (int i = 0; i < 4; ++i) { v0[i] = gelu_tanh(v0[i]); v1[i] = gelu_tanh(v1[i]); }
                }
                if (ZM == 1) { if ((row & 511) == 511) { v0 = (f32x4){0.f, 0.f, 0.f, 0.f}; v1 = v0; } }
                if (ZM == 2) { if (((col0 + 7) & 511) == 511) v1[3] = 0.f; }
                *(u32x4*)(O + (size_t)row * ld + col0) = pack8(v0, v1);
            }
        }
    }
};
struct EpiSec {
    unsigned char* ws; unsigned char* dout;
    DI void operator()(const f32x4 (&acc)[2][2][4][2], const Unit& u, int wr, int wc, int fr, int fq) const {
        const int pn = u.pn; bf16* base; int ld, c0, nc = 256;
        if (pn < 12) { base = (bf16*)(ws + WS_XR + (size_t)(pn >> 2) * 128 * MiB); ld = 1024; c0 = (pn & 3) * 256; }
        else if (pn < 16) { base = (bf16*)(ws + WS_KC + (size_t)(pn - 12) * 32 * MiB); ld = 256; c0 = 0; }
        else if (pn < 20) { base = (bf16*)(dout + 128 * MiB); ld = 1024; c0 = (pn - 16) * 256; }
        else if (pn < 24) { base = (bf16*)(ws + WS_GMA); ld = 1024; c0 = (pn - 20) * 256; }
        else { base = (bf16*)(ws + WS_GNSA); ld = 64; c0 = 0; nc = 64; }
        const float qs = (pn >= 8 && pn < 12) ? 0.125f * LOG2E : 1.f;
#pragma unroll
        EPI_LOOP {
            const int row = u.pm * 256 + ai * 128 + wr * 64 + m * 16 + fr, cl = bj * 128 + wc * 32 + 8 * fq;
            if (cl < nc) __builtin_nontemporal_store(pack8(acc[ai][bj][m][0] * qs, acc[ai][bj][m][1] * qs), (u32x4*)(base + (size_t)row * ld + c0 + cl));
        }
    }
};
struct EpiSwi {
    bf16* O;
    DI void operator()(const f32x4 (&acc)[2][2][4][2], const Unit& u, int wr, int wc, int fr, int fq) const {
#pragma unroll
        for (int ai = 0; ai < 2; ++ai)
#pragma unroll
            for (int m = 0; m < 4; ++m) {
                const int row = u.pm * 256 + ai * 128 + wr * 64 + m * 16 + fr, col0 = u.pn * 128 + wc * 32 + 8 * fq;
                f32x4 v0, v1;
#pragma unroll
                for (int i = 0; i < 4; ++i) { const float g0 = acc[ai][0][m][0][i], g1 = acc[ai][0][m][1][i];
                    v0[i] = g0 * sigmoidf_(g0) * acc[ai][1][m][0][i]; v1[i] = g1 * sigmoidf_(g1) * acc[ai][1][m][1][i]; }
                __builtin_nontemporal_store(pack8(v0, v1), (u32x4*)(O + (size_t)row * DFF + col0));
                asm volatile("" ::: "memory");
            }
    }
};
struct EpiPle {
    float* out; const bf16* xb; const bf16* pp; const float* bias;
    DI void operator()(const f32x4 (&acc)[2][2][4][2], const Unit& u, int wr, int wc, int fr, int fq) const {
        f32x4 b0[2], b1[2];
#pragma unroll
        for (int bj = 0; bj < 2; ++bj) { const int col0 = u.pn * 256 + bj * 128 + wc * 32 + 8 * fq; b0[bj] = *(const f32x4*)(bias + col0); b1[bj] = *(const f32x4*)(bias + col0 + 4); }
#pragma unroll
        for (int ai = 0; ai < 2; ++ai) {
            u32x4 pw[4][2], xw[4][2];
#pragma unroll
            for (int m = 0; m < 4; ++m)
#pragma unroll
                for (int bj = 0; bj < 2; ++bj) {
                    const size_t off = (size_t)(u.pm * 256 + ai * 128 + wr * 64 + m * 16 + fr) * DM + u.pn * 256 + bj * 128 + wc * 32 + 8 * fq;
                    pw[m][bj] = *(const u32x4*)(pp + off); xw[m][bj] = *(const u32x4*)(xb + off);
                }
#pragma unroll
            for (int m = 0; m < 4; ++m)
#pragma unroll
                for (int bj = 0; bj < 2; ++bj) {
                    const size_t off = (size_t)(u.pm * 256 + ai * 128 + wr * 64 + m * 16 + fr) * DM + u.pn * 256 + bj * 128 + wc * 32 + 8 * fq;
                    const u32x4 p = pw[m][bj], x = xw[m][bj];
                    const f32x4 a0 = acc[ai][bj][m][0] + b0[bj], a1 = acc[ai][bj][m][1] + b1[bj];
                    f32x4 x0, x1;
                    x0[0] = bflo(x.x) + sigmoidf_(a0[0]) * bflo(p.x); x0[1] = bfhi(x.x) + sigmoidf_(a0[1]) * bfhi(p.x); x0[2] = bflo(x.y) + sigmoidf_(a0[2]) * bflo(p.y); x0[3] = bfhi(x.y) + sigmoidf_(a0[3]) * bfhi(p.y);
                    x1[0] = bflo(x.z) + sigmoidf_(a1[0]) * bflo(p.z); x1[1] = bfhi(x.z) + sigmoidf_(a1[1]) * bfhi(p.z); x1[2] = bflo(x.w) + sigmoidf_(a1[2]) * bflo(p.w); x1[3] = bfhi(x.w) + sigmoidf_(a1[3]) * bfhi(p.w);
                    *(f32x4*)(out + off) = x0; *(f32x4*)(out + off + 4) = x1;
                }
        }
    }
};
}

DI int map_row(int mode, int n) {
    if (mode == 1) {
        if (n < 3840) return n;
        if (n < 4096) return 6400 + (n - 3840);
        if (n < 4352) return 3840 + (n - 4096);
        if (n < 4608) return 6656 + (n - 4352);
        if (n < 4656) return 6144 + (n - 4608);
        if (n < 5680) return 4096 + (n - 4656);
        return 5120 + (n - 5680);
    }
    if (mode == 2) {
        if (n < DFF) return 256 * (n >> 7) + (n & 127);
        const int uu = n - DFF; return 256 * (uu >> 7) + 128 + (uu & 127);
    }
    return n;
}
DI void transpose_item(const float* W, int K, int N, bf16* WT, int mode, LAS float* scr, int item, int lane) {
    const int nblk = (N + 31) / 32, kb = item / nblk, nb = item % nblk, k0 = 64 * kb, n0 = 32 * nb;
    const int r8 = lane >> 3, c4 = lane & 7;
    const bool okr = (n0 + 4 * c4) < N;
#pragma unroll
    for (int i = 0; i < 8; ++i) { const int kk = 8 * i + r8;
        const f32x4 v = okr ? *(const f32x4*)(W + (size_t)(k0 + kk) * N + n0 + 4 * c4) : (f32x4){0.f, 0.f, 0.f, 0.f};
        LAS float* d = scr + kk * 33 + 4 * c4; d[0] = v.x; d[1] = v.y; d[2] = v.z; d[3] = v.w; }
    LDS_WAIT(); asm volatile("" ::: "memory");
    const int c = lane & 7;
#pragma unroll
    for (int j = 0; j < 4; ++j) { const int n = (lane >> 3) + 8 * j; const LAS float* s = scr + (8 * c) * 33 + n;
        u32x4 o; o.x = pk2(s[0 * 33], s[1 * 33]); o.y = pk2(s[2 * 33], s[3 * 33]); o.z = pk2(s[4 * 33], s[5 * 33]); o.w = pk2(s[6 * 33], s[7 * 33]);
        if (n0 + n < N) *(u32x4*)(WT + (size_t)map_row(mode, n0 + n) * K + k0 + 8 * c) = o; }
    LDS_WAIT(); asm volatile("" ::: "memory");
}
template <int RR>
DI void rms_rows_to_bf16(const float* X, const float* g, bf16* Out, int m0, int stride, int lane) {
    f32x4 v[RR][4]; float s[RR];
#pragma unroll
    for (int r = 0; r < RR; ++r) { const f32x4* xr = (const f32x4*)(X + (size_t)(m0 + r * stride) * DM) + lane;
#pragma unroll
        for (int j = 0; j < 4; ++j) v[r][j] = xr[64 * j]; }
    f32x4 gg[4];
#pragma unroll
    for (int j = 0; j < 4; ++j) gg[j] = ((const f32x4*)g + lane)[64 * j];
#pragma unroll
    for (int r = 0; r < RR; ++r) { s[r] = 0.f;
#pragma unroll
        for (int j = 0; j < 4; ++j) s[r] += (v[r][j].x * v[r][j].x + v[r][j].y * v[r][j].y) + (v[r][j].z * v[r][j].z + v[r][j].w * v[r][j].w); }
#pragma unroll
    for (int r = 0; r < RR; ++r) {
        const float rs = rsqrtf(wave_sum(s[r]) * (1.f / DM) + NORM_EPS);
        u64* o8 = (u64*)(Out + (size_t)(m0 + r * stride) * DM) + lane;
#pragma unroll
        for (int j = 0; j < 4; ++j) o8[64 * j] = (u64)pk2(v[r][j].x * rs * gg[j].x, v[r][j].y * rs * gg[j].y) | ((u64)pk2(v[r][j].z * rs * gg[j].z, v[r][j].w * rs * gg[j].w) << 32);
    }
}

struct Args { const float* in[26]; float* out; unsigned char* ws; int ph_lo, ph_hi; };

DI void p0_prologue(const int wv, const Args& A, LAS unsigned char* lds, int G) {
    const int tid = TIDX, lane = tid & 63, wave = wv;
    unsigned char* ws = A.ws;
    if (blockIdx.x == 0 && tid < 8) ((unsigned*)(ws + WS_CTR))[tid * 16] = 0u;
    for (int it = blockIdx.x; it < 256; it += G) {
        const int mat = tid >> 8, j = tid & 255;
        const float* pos = A.in[12 + mat]; const float* w1 = A.in[mat ? 16 : 14];
        float s = 0.f;
#pragma unroll
        for (int k = 8 * it; k < 8 * it + 8; ++k) s += pos[k] * w1[(size_t)k * 256 + j];
        ((float*)(ws + WS_PART))[it * 512 + tid] = s;
    }
    LAS float* scr = (LAS float*)(lds + wave * 16384);
    const int gw = blockIdx.x * NWAVES + wave, NGW = G * NWAVES;
    constexpr int I_IN = 16 * 210, I_OUT = 16 * 32, I_GU = 16 * 176, I_DN = 44 * 32, I_PG = 16 * 32, I_PP = 4 * 32, I_C1 = 32 * 8, I_C2 = 4 * 2, I_L = 2;
    constexpr int NITEMS = I_IN + I_OUT + I_GU + I_DN + I_PG + I_PP + 2 * I_C1 + 2 * I_C2 + 32 * I_L;
    for (int it = gw; it < NITEMS; it += NGW) {
        int r = it;
        if (r < I_IN) { transpose_item(A.in[4], DM, DIN, (bf16*)(ws + WS_WIN), 1, scr, r, lane); continue; } r -= I_IN;
        if (r < I_OUT) { transpose_item(A.in[18], DM, DM, (bf16*)(ws + WS_WOUT), 0, scr, r, lane); continue; } r -= I_OUT;
        if (r < I_GU) { transpose_item(A.in[21], DM, 2 * DFF, (bf16*)(ws + WS_WGU), 2, scr, r, lane); continue; } r -= I_GU;
        if (r < I_DN) { transpose_item(A.in[22], DFF, DM, (bf16*)(ws + WS_WDN), 0, scr, r, lane); continue; } r -= I_DN;
        if (r < I_PG) { transpose_item(A.in[24], DM, DM, (bf16*)(ws + WS_WPG), 0, scr, r, lane); continue; } r -= I_PG;
        if (r < I_PP) { transpose_item(A.in[23], DPLE, DM, (bf16*)(ws + WS_WPP), 0, scr, r, lane); continue; } r -= I_PP;
        if (r < I_C1) { transpose_item(A.in[14], 2048, 256, (bf16*)(ws + WS_CW1K), 0, scr, r, lane); continue; } r -= I_C1;
        if (r < I_C1) { transpose_item(A.in[16], 2048, 256, (bf16*)(ws + WS_CW1V), 0, scr, r, lane); continue; } r -= I_C1;
        if (r < I_C2) { transpose_item(A.in[15], 256, 64, (bf16*)(ws + WS_CW2K), 0, scr, r, lane); continue; } r -= I_C2;
        if (r < I_C2) { transpose_item(A.in[17], 256, 64, (bf16*)(ws + WS_CW2V), 0, scr, r, lane); continue; } r -= I_C2;
        { const int mat = r / (16 * I_L), rr = r % (16 * I_L), nb = rr / I_L, sub = rr % I_L;
          transpose_item(A.in[mat ? 9 : 7] + (size_t)nb * 4096, 64, 64, (bf16*)(ws + (mat ? WS_LWX : WS_LWA)) + (size_t)nb * 4096, 0, scr, sub, lane); }
    }
    bf16* H = (bf16*)A.out;
    { int m = gw;
      for (; m + 7 * NGW < MTOK; m += 8 * NGW) rms_rows_to_bf16<8>(A.in[0], A.in[2], H, m, NGW, lane);
      for (; m + 3 * NGW < MTOK; m += 4 * NGW) rms_rows_to_bf16<4>(A.in[0], A.in[2], H, m, NGW, lane);
      for (; m < MTOK; m += NGW) rms_rows_to_bf16<1>(A.in[0], A.in[2], H, m, NGW, lane); }
}

constexpr int SC_W = 18432, SC_SLOT = 16640;
template <int PASS>
DI void scan_item(const int wv, const Args& A, LAS unsigned char* lds, int item) {
    const int tid = TIDX, lane = tid & 63, wave = wv, fr = lane & 15, fq = lane >> 4;
    const int cg8 = item & 7, nblk = (item >> 3) & 15, b = item >> 7;
    const int j = cg8 * 8 + wave, ch = nblk * 64 + lane;
    unsigned char* ws = A.ws;
    const bf16* XR = (const bf16*)(ws + WS_XR); const bf16* GR = (const bf16*)(ws + WS_GR); const bf16* GMR = (const bf16*)((unsigned char*)A.out + 128 * MiB);
    bf16* Y = (bf16*)A.out;
    float2* AGG = (float2*)(ws + WS_AGG2);
    bf16* CT = (bf16*)(ws + WS_CT);
#pragma unroll
    for (int k = 0; k < 2; ++k) { const int id = tid + 512 * k, mat = id >> 9, row = (id >> 3) & 63, c8 = id & 7;
        const bf16* src = (const bf16*)(ws + (mat ? WS_LWX : WS_LWA)) + (size_t)nblk * 4096 + row * 64 + c8 * 8;
        *(LAS u32x4*)(lds + mat * 9216 + row * 144 + c8 * 16) = *(const u32x4*)src; }
    LAS unsigned char* wl = lds + SC_W + wave * SC_SLOT;
    LAS float* pre_r = (LAS float*)wl;
    LAS float* pre_i = (LAS float*)(wl + 4096);
    LAS bf16* xcb = (LAS bf16*)(wl + 8192);
    LAS bf16* SX = (LAS bf16*)(wl + 10496);
    LAS bf16* SG = (LAS bf16*)(wl + 12544);
    LAS bf16* SM = (LAS bf16*)(wl + 14592);
    const float cw0 = A.in[5][ch], cw1 = A.in[5][DM + ch], cw2 = A.in[5][2 * DM + ch], cw3 = A.in[5][3 * DM + ch], cb = A.in[6][ch];
    const float ba = A.in[8][ch], bx = A.in[10][ch];
    const float sp8 = -8.f * log1pf(__expf(-A.in[11][ch]));
    const int t0 = j * 128;
    const size_t rowb = (size_t)b * SEQ;
    float xm3 = 0.f, xm2 = 0.f, xm1 = 0.f;
    if (t0 > 0) { xm3 = bf2f(XR[(rowb + t0 - 3) * DM + ch]); xm2 = bf2f(XR[(rowb + t0 - 2) * DM + ch]); xm1 = bf2f(XR[(rowb + t0 - 1) * DM + ch]); }
    float h = 0.f, P = 1.f;
    const int ptok = lane >> 3, pc8 = lane & 7;
    const size_t gpiece = (size_t)ptok * DM + nblk * 64 + pc8 * 8;
    const int lpiece = ptok * 128 + pc8 * 16;
    u32x4 rx[2], rg[2], rm[2];
#pragma unroll
    for (int k = 0; k < 2; ++k) { const size_t o = (rowb + t0) * DM + gpiece + (size_t)k * 8 * DM;
        rx[k] = *(const u32x4*)(XR + o); rg[k] = *(const u32x4*)(GR + o); rm[k] = *(const u32x4*)(GMR + o); }
    __syncthreads();
    for (int step = 0; step < 8; ++step) {
        const int ts = t0 + step * 16;
#pragma unroll
        for (int k = 0; k < 2; ++k) { *(LAS u32x4*)((LAS unsigned char*)SX + lpiece + k * 1024) = rx[k]; *(LAS u32x4*)((LAS unsigned char*)SG + lpiece + k * 1024) = rg[k]; *(LAS u32x4*)((LAS unsigned char*)SM + lpiece + k * 1024) = rm[k]; }
        if (step < 7) {
#pragma unroll
            for (int k = 0; k < 2; ++k) { const size_t o = (rowb + ts + 16) * DM + gpiece + (size_t)k * 8 * DM;
                rx[k] = *(const u32x4*)(XR + o); rg[k] = *(const u32x4*)(GR + o); rm[k] = *(const u32x4*)(GMR + o); }
        }
        __syncthreads();
        float xc[16];
#pragma unroll
        for (int tt = 0; tt < 16; ++tt) {
            const float x = bf2f(SX[tt * 64 + lane]);
            xc[tt] = cb + cw0 * xm3 + cw1 * xm2 + cw2 * xm1 + cw3 * x;
            xm3 = xm2; xm2 = xm1; xm1 = x;
            xcb[tt * 72 + lane] = (bf16)f2bf(xc[tt]);
        }
        __syncthreads();
        {
            f32x4 ar[4], ai[4];
#pragma unroll
            for (int nt = 0; nt < 4; ++nt) { ar[nt] = (f32x4){0.f, 0.f, 0.f, 0.f}; ai[nt] = ar[nt]; }
#pragma unroll
            for (int ks = 0; ks < 2; ++ks) {
                const bf16x8 af = *(const LAS bf16x8*)(xcb + fr * 72 + ks * 32 + fq * 8);
#pragma unroll
                for (int nt = 0; nt < 4; ++nt) {
                    const bf16x8 wa = *(const LAS bf16x8*)(lds + (nt * 16 + fr) * 144 + ks * 64 + fq * 16);
                    const bf16x8 wx = *(const LAS bf16x8*)(lds + 9216 + (nt * 16 + fr) * 144 + ks * 64 + fq * 16);
                    ar[nt] = __builtin_amdgcn_mfma_f32_16x16x32_bf16(af, wa, ar[nt], 0, 0, 0); ai[nt] = __builtin_amdgcn_mfma_f32_16x16x32_bf16(af, wx, ai[nt], 0, 0, 0); }
            }
#pragma unroll
            for (int nt = 0; nt < 4; ++nt)
#pragma unroll
                for (int q = 0; q < 4; ++q) { pre_r[(fq * 4 + q) * 64 + nt * 16 + fr] = ar[nt][q]; pre_i[(fq * 4 + q) * 64 + nt * 16 + fr] = ai[nt][q]; }
        }
        __syncthreads();
        {
            const f32x2_t ba2 = {ba, ba}, bx2 = {bx, bx}, sp2 = {sp8, sp8}, one2 = {1.f, 1.f};
            const f32x2_t nl2e = {-LOG2E, -LOG2E}, l2e = {LOG2E, LOG2E};
            LAS bf16* SY = SX; LAS bf16* SC = xcb;
#pragma unroll
            for (int tt = 0; tt < 16; tt += 2) {
                const f32x2_t pr = (f32x2_t){pre_r[tt * 64 + lane], pre_r[(tt + 1) * 64 + lane]} + ba2;
                const f32x2_t pi = (f32x2_t){pre_i[tt * 64 + lane], pre_i[(tt + 1) * 64 + lane]} + bx2;
                const f32x2_t cap = {60.f, 60.f};
                const f32x2_t tr = __builtin_elementwise_min(pr * nl2e, cap), ti = __builtin_elementwise_min(pi * nl2e, cap);
                const f32x2_t dr = (f32x2_t){__builtin_amdgcn_exp2f(tr.x), __builtin_amdgcn_exp2f(tr.y)} + one2;
                const f32x2_t di = (f32x2_t){__builtin_amdgcn_exp2f(ti.x), __builtin_amdgcn_exp2f(ti.y)} + one2;
                const f32x2_t dd = dr * di;
                const f32x2_t inv = {__builtin_amdgcn_rcpf(dd.x), __builtin_amdgcn_rcpf(dd.y)};
                const f32x2_t r = inv * di, ig = inv * dr;
                const f32x2_t la = r * sp2;
                const f32x2_t tl = la * l2e;
                const f32x2_t a = {__builtin_amdgcn_exp2f(tl.x), __builtin_amdgcn_exp2f(tl.y)};
                const f32x2_t x2 = la + la;
                f32x2_t om = x2 * (f32x2_t){1.f / 720.f, 1.f / 720.f} + (f32x2_t){1.f / 120.f, 1.f / 120.f};
                om = om * x2 + (f32x2_t){1.f / 24.f, 1.f / 24.f}; om = om * x2 + (f32x2_t){1.f / 6.f, 1.f / 6.f}; om = om * x2 + (f32x2_t){0.5f, 0.5f}; om = om * x2 + one2;
                om = om * (-x2);
                if (__builtin_amdgcn_ballot_w64((x2.x <= -0.25f) || (x2.y <= -0.25f)) != 0ull) {
                    asm volatile("" ::: "memory");
                    if (x2.x <= -0.25f) om.x = 1.f - a.x * a.x;
                    if (x2.y <= -0.25f) om.y = 1.f - a.y * a.y;
                }
                const f32x2_t omx = __builtin_elementwise_max(om, (f32x2_t){0.f, 0.f});
                const f32x2_t sq = {__builtin_amdgcn_sqrtf(omx.x), __builtin_amdgcn_sqrtf(omx.y)};
                const f32x2_t bb = sq * (ig * (f32x2_t){xc[tt], xc[tt + 1]});
                const float h0 = a.x * h + bb.x;
                const float h1 = a.y * h0 + bb.y;
                h = h1;
                const float P0 = P * a.x, P1 = P0 * a.y;
                P = P1;
                const f32x2_t gvv = {bf2f(SG[tt * 64 + lane]), bf2f(SG[(tt + 1) * 64 + lane])}, gmv = {bf2f(SM[tt * 64 + lane]), bf2f(SM[(tt + 1) * 64 + lane])};
                const f32x2_t g2 = gvv * gvv;
                const f32x2_t uu = gvv * (g2 * (f32x2_t){0.044715f, 0.044715f} + one2);
                const f32x2_t tg = __builtin_elementwise_min(uu * (f32x2_t){-2.f * 0.7978845608028654f * LOG2E, -2.f * 0.7978845608028654f * LOG2E}, cap), tm = __builtin_elementwise_min(gmv * nl2e, cap);
                const f32x2_t dg = (f32x2_t){__builtin_amdgcn_exp2f(tg.x), __builtin_amdgcn_exp2f(tg.y)} + one2;
                const f32x2_t dm = (f32x2_t){__builtin_amdgcn_exp2f(tm.x), __builtin_amdgcn_exp2f(tm.y)} + one2;
                const f32x2_t dq = dg * dm;
                const f32x2_t iq = {__builtin_amdgcn_rcpf(dq.x), __builtin_amdgcn_rcpf(dq.y)};
                const f32x2_t gq = gvv * iq;
                const f32x2_t yv = (f32x2_t){h0, h1} * gq, cv = (f32x2_t){P0, P1} * gq;
                SY[tt * 64 + lane] = (bf16)f2bf(yv.x); SY[(tt + 1) * 64 + lane] = (bf16)f2bf(yv.y);
                SC[tt * 64 + lane] = (bf16)f2bf(cv.x); SC[(tt + 1) * 64 + lane] = (bf16)f2bf(cv.y);
            }
        }
        __syncthreads();
#pragma unroll
        for (int k = 0; k < 2; ++k) { const size_t o = (rowb + ts) * DM + gpiece + (size_t)k * 8 * DM;
            *(u32x4*)(Y + o) = *(const LAS u32x4*)((LAS unsigned char*)SX + lpiece + k * 1024);
            *(u32x4*)(CT + o) = *(const LAS u32x4*)((LAS unsigned char*)xcb + lpiece + k * 1024); }
        __syncthreads();
    }
    AGG[((size_t)b * 64 + j) * DM + ch] = make_float2(P, h);
}

struct ACtx { int h, n, qi, r, t, wave; float slope2; unsigned slopew, slope16w; bf16x8 qf[4], akey[2]; u64 sel_lo, sel_hi, wun_lo, wun_hi; };
DI int m128_first(u64 lo, u64 hi) { return lo ? (__ffsll((long long)lo) - 1) : (hi ? 64 + (__ffsll((long long)hi) - 1) : -1); }
DI int m128_last(u64 lo, u64 hi) { return hi ? (127 - __clzll((long long)hi)) : (lo ? (63 - __clzll((long long)lo)) : -1); }
DI bool m128_bit(u64 lo, u64 hi, int j) { return j < 64 ? ((lo >> j) & 1ull) : ((hi >> (j - 64)) & 1ull); }
DI void m128_clear(u64& lo, u64& hi, int j) { if (j < 64) lo &= ~(1ull << j); else hi &= ~(1ull << (j - 64)); }
#define MFMA32(a, b, c) __builtin_amdgcn_mfma_f32_32x32x16_bf16((a), (b), (c), 0, 0, 0)

template <int BR, int NT, int DV>
DI void attn_compute(LAS unsigned char* kbA, LAS unsigned char* vbA, LAS unsigned char* kbB, LAS unsigned char* vbB, const int jA, const int jB,
                     const ACtx& c, const int qb, float& m, float& l, f32x16 (&O)[2], float m_fin, float inv_l, LAS float* imp_row, float& carry) {
    f32x16 s[2 * NT];
#pragma unroll
    for (int ti = 0; ti < NT; ++ti) {
        LAS unsigned char* kb = ti ? kbB : kbA; const int j = ti ? jB : jA;
#pragma unroll
        for (int i = 0; i < 16; ++i) { s[2 * ti][i] = 0.f; s[2 * ti + 1][i] = 0.f; }
#pragma unroll
        for (int ks = 0; ks < ((DV & 4) ? 0 : 4); ++ks) {
            const bf16x8 a0 = *(const LAS bf16x8*)(kb + c.n * 144 + ks * 32 + c.h * 16);
            const bf16x8 a1 = *(const LAS bf16x8*)(kb + (32 + c.n) * 144 + ks * 32 + c.h * 16);
            s[2 * ti] = MFMA32(a0, c.qf[ks], s[2 * ti]); s[2 * ti + 1] = MFMA32(a1, c.qf[ks], s[2 * ti + 1]);
        }
        {
            const int pos0 = (BR <= 1) ? (1024 * j + 31 - c.t) : (64 * j - c.t);
            float tb = c.slope2 * (float)pos0;
            if (BR == 2) { if (!m128_bit(c.sel_lo, c.sel_hi, j)) tb = -1e30f; }
            const unsigned thi = f2bf(tb); const unsigned tlo = f2bf(tb - bf2f(thi));
            u32x4 bw = (u32x4){(BR <= 1) ? c.slope16w : c.slopew, thi | (tlo << 16), 0u, 0u};
            if (c.h) bw = (u32x4){0u, 0u, 0u, 0u};
            const bf16x8 bb = __builtin_bit_cast(bf16x8, bw);
            s[2 * ti] = MFMA32(c.akey[0], bb, s[2 * ti]); s[2 * ti + 1] = MFMA32(c.akey[1], bb, s[2 * ti + 1]);
        }
        bool bnd;
        if (BR <= 1) bnd = (64 * j + 63 > 4 * qb - 2); else if (BR == 2) bnd = (j == qb); else bnd = (j == qb) || (j + 8 == qb);
        if (bnd) {
            asm volatile("" ::: "memory");
            const int d0 = (BR <= 1) ? (c.t - 31 - 1024 * j) : (c.t - 64 * j);
#pragma unroll
            for (int kt = 0; kt < 2; ++kt)
#pragma unroll
                for (int rr = 0; rr < 16; ++rr) {
                    const int key = kt * 32 + (rr & 3) + 8 * (rr >> 2) + 4 * c.h;
                    const int dist = (BR <= 1) ? (d0 - 16 * key) : (d0 - key);
                    bool valid = dist >= 0;
                    if (BR == 3) valid = valid && (dist < 512);
                    s[2 * ti + kt][rr] = valid ? s[2 * ti + kt][rr] : -INFINITY;
                }
        }
    }
    float m_use, alpha = 1.f; bool grow = false;
    float mx = -INFINITY;
#pragma unroll
    for (int q = 0; q < 2 * NT; ++q)
#pragma unroll
        for (int i = 0; i < 16; ++i) mx = fmaxf(mx, s[q][i]);
    if (BR == 1) { m_use = m_fin; }
    else {
        mx = fmaxf(mx, __shfl_xor(mx, 32));
        if (mx < -1e29f) mx = -INFINITY;
        const float m_new = fmaxf(m, mx);
        grow = m_new > m;
        m_use = (m_new == -INFINITY) ? 0.f : m_new;
        alpha = __builtin_amdgcn_exp2f(m - m_use);
        m = m_new;
    }
    if (__builtin_amdgcn_ballot_w64((mx - m_use) > -150.f) == 0ull) {
        if (BR == 1) {
#pragma unroll
            for (int ti = 0; ti < NT; ++ti)
#pragma unroll
                for (int kt = 0; kt < 2; ++kt)
#pragma unroll
                    for (int v = 0; v < 4; ++v) { const int j = ti ? jB : jA; const float add = c.h ? 0.f : carry; carry = 0.f; if (c.r == 0) imp_row[16 * j + 8 * kt + 2 * v + c.h] = add; }
        }
        return;
    }
    f32x2_t sum2 = {0.f, 0.f}; const f32x2_t mm2 = {m_use, m_use}, il2 = {inv_l, inv_l};
#pragma unroll
    for (int q = 0; q < 2 * NT; ++q)
#pragma unroll
        for (int rr = 0; rr < 16; rr += 2) {
            const f32x2_t d = (f32x2_t){s[q][rr], s[q][rr + 1]} - mm2;
            f32x2_t p = (DV & 1) ? d : (f32x2_t){__builtin_amdgcn_exp2f(d.x), __builtin_amdgcn_exp2f(d.y)};
            if (BR == 1) p *= il2;
            s[q][rr] = p.x; s[q][rr + 1] = p.y; sum2 += p;
        }
    float sum = sum2.x + sum2.y;
    if (BR != 1) { sum += __shfl_xor(sum, 32); l = l * alpha + sum; }
    if (BR == 1) {
#pragma unroll
        for (int ti = 0; ti < NT; ++ti)
#pragma unroll
            for (int kt = 0; kt < 2; ++kt)
#pragma unroll
                for (int v = 0; v < 4; ++v) {
                    const int j = ti ? jB : jA;
                    float a = 2.f * (s[2 * ti + kt][4 * v] + s[2 * ti + kt][4 * v + 1] + s[2 * ti + kt][4 * v + 2]) + s[2 * ti + kt][4 * v + 3], bc = s[2 * ti + kt][4 * v + 3];
                    a += dpp_f<0xB1>(a); a += dpp_f<0x4E>(a); bc += dpp_f<0xB1>(bc); bc += dpp_f<0x4E>(bc);
                    const float bo = __shfl_xor(bc, 32);
                    const float add = a + (c.h ? bo : carry);
                    carry = bo;
                    if (c.r == 0) imp_row[16 * j + 8 * kt + 2 * v + c.h] = add;
                }
    }
    if (BR != 0) {
        if (BR != 1) {
            if (__builtin_amdgcn_ballot_w64(grow) != 0ull) {
#pragma unroll
                for (int i = 0; i < 16; ++i) { O[0][i] *= alpha; O[1][i] *= alpha; }
            }
        }
        if (!(DV & 2) && __builtin_amdgcn_ballot_w64(sum > 0.f) != 0ull) {
#pragma unroll
            for (int ti = 0; ti < NT; ++ti)
#pragma unroll
                for (int kt = 0; kt < 2; ++kt)
#pragma unroll
                    for (int u = 0; u < 2; ++u) {
                        LAS unsigned char* vb = ti ? vbB : vbA;
                        const f32x16& sv = s[2 * ti + kt];
                        u32x4 pw; pw.x = pk2(sv[8 * u], sv[8 * u + 1]); pw.y = pk2(sv[8 * u + 2], sv[8 * u + 3]); pw.z = pk2(sv[8 * u + 4], sv[8 * u + 5]); pw.w = pk2(sv[8 * u + 6], sv[8 * u + 7]);
                        const bf16x8 pf = __builtin_bit_cast(bf16x8, pw);
                        const int kbase = kt * 32 + 16 * u;
#pragma unroll
                        for (int mt = 0; mt < 2; ++mt) {
                            const LAS unsigned char* vp = vb + (mt * 32 + c.n) * 136 + (kbase + 4 * c.h) * 2;
                            const u32x2 lo = *(const LAS u32x2*)vp, hi = *(const LAS u32x2*)(vp + 16);
                            const bf16x8 af = __builtin_bit_cast(bf16x8, (u32x4){lo.x, lo.y, hi.x, hi.y});
                            O[mt] = MFMA32(af, pf, O[mt]);
                        }
                    }
        }
    }
}

constexpr int AT_PAIR = 35840, AT_K1 = 9216, AT_V0 = 18432, AT_V1 = 18432 + 8704;
template <int BR, int DV>
DI void attn_tiles(const int wv, LAS unsigned char* lds, const bf16* Kbase, size_t ldk, size_t ktile, const bf16* Vbase, size_t ldv, size_t vtile,
                   u64 mlo, u64 mhi, const ACtx& c, const int qb, float& m, float& l, f32x16 (&O)[2], float m_fin, float inv_l, LAS float* imp_row, float& carry) {
    constexpr bool DESC = (BR >= 2) || (BR == 0);
    const int tid = TIDX, srow = tid >> 3, sch = tid & 7;
#define AT_NEXT() (DESC ? m128_last(mlo, mhi) : m128_first(mlo, mhi))
#define AT_LOAD(RK, RV, JJ) do { RK = *(const u32x4*)(Kbase + (size_t)(JJ) * ktile + (size_t)srow * ldk + sch * 8); \
        if (BR != 0) RV = *(const u32x4*)(Vbase + (size_t)(JJ) * vtile + (size_t)srow * ldv + sch * 8); } while (0)
#define AT_WRITE(RK, RV, KOFF, VOFF) do { *(LAS u32x4*)(pb + (KOFF) + srow * 144 + sch * 16) = RK; \
        if (BR != 0) { *(LAS u32x2*)(pb + (VOFF) + srow * 136 + sch * 16) = (u32x2){RV.x, RV.y}; *(LAS u32x2*)(pb + (VOFF) + srow * 136 + sch * 16 + 8) = (u32x2){RV.z, RV.w}; } } while (0)
    int j0 = AT_NEXT();
    if (j0 < 0) return;
    m128_clear(mlo, mhi, j0);
    int j1 = AT_NEXT();
    if (j1 >= 0) m128_clear(mlo, mhi, j1);
    u32x4 rk0, rv0 = (u32x4){0u, 0u, 0u, 0u}, rk1 = (u32x4){0u, 0u, 0u, 0u}, rv1 = (u32x4){0u, 0u, 0u, 0u};
    AT_LOAD(rk0, rv0, j0);
    if (j1 >= 0) AT_LOAD(rk1, rv1, j1);
    int buf = 0;
    __syncthreads();
    while (j0 >= 0) {
        LAS unsigned char* pb = lds + buf * AT_PAIR;
        AT_WRITE(rk0, rv0, 0, AT_V0);
        if (j1 >= 0) AT_WRITE(rk1, rv1, AT_K1, AT_V1);
        int n0 = (j1 >= 0) ? AT_NEXT() : -1;
        if (n0 >= 0) m128_clear(mlo, mhi, n0);
        int n1 = (n0 >= 0) ? AT_NEXT() : -1;
        if (n1 >= 0) m128_clear(mlo, mhi, n1);
        if (n0 >= 0) AT_LOAD(rk0, rv0, n0);
        if (n1 >= 0) AT_LOAD(rk1, rv1, n1);
        __syncthreads();
        const bool act0 = (BR != 2) || m128_bit(c.wun_lo, c.wun_hi, j0);
        const bool act1 = (j1 >= 0) && ((BR != 2) || m128_bit(c.wun_lo, c.wun_hi, j1));
        if (act0 && act1) attn_compute<BR, 2, DV>(pb, pb + AT_V0, pb + AT_K1, pb + AT_V1, j0, j1, c, qb, m, l, O, m_fin, inv_l, imp_row, carry);
        else if (act0) attn_compute<BR, 1, DV>(pb, pb + AT_V0, pb, pb + AT_V0, j0, j0, c, qb, m, l, O, m_fin, inv_l, imp_row, carry);
        else if (act1) attn_compute<BR, 1, DV>(pb + AT_K1, pb + AT_V1, pb + AT_K1, pb + AT_V1, j1, j1, c, qb, m, l, O, m_fin, inv_l, imp_row, carry);
        j0 = n0; j1 = n1; buf ^= 1;
    }
#undef AT_NEXT
#undef AT_LOAD
#undef AT_WRITE
}

template <int DV>
DI void attn_unit(const int wv, const Args& A, LAS unsigned char* lds, int b, int g, int qb, int dry) {
    const int tid = TIDX, lane = tid & 63, wave = wv;
    unsigned char* ws = A.ws;
    ACtx c; c.h = lane >> 5; c.n = lane & 31; c.qi = c.n >> 2; c.r = c.n & 3; c.wave = wave; c.t = qb * 64 + wave * 8 + c.qi;
    const int head = g * 4 + c.r;
    c.slope2 = __builtin_amdgcn_exp2f(-0.5f * (float)(head + 1)) * LOG2E;
    { const unsigned shi = f2bf(c.slope2); const float slo = c.slope2 - bf2f(shi); c.slopew = shi | (f2bf(slo) << 16); c.slope16w = f2bf(16.f * bf2f(shi)) | (f2bf(16.f * slo) << 16);
#pragma unroll
      for (int kt = 0; kt < 2; ++kt) { const unsigned kk = f2bf((float)(kt * 32 + c.n)); u32x4 aw = (u32x4){kk | (kk << 16), 0x3F803F80u, 0u, 0u}; if (c.h) aw = (u32x4){0u, 0u, 0u, 0u}; c.akey[kt] = __builtin_bit_cast(bf16x8, aw); } }
    c.sel_lo = c.sel_hi = c.wun_lo = c.wun_hi = 0ull;
    const size_t tokrow = (size_t)b * SEQ + c.t;
    { const bf16* q = (const bf16*)(ws + WS_Q) + tokrow * DM + head * 64 + 8 * c.h;
#pragma unroll
      for (int ks = 0; ks < 4; ++ks) c.qf[ks] = *(const bf16x8*)(q + ks * 16); }
    LAS float* IMP = (LAS float*)(lds + 71680);
    LAS u64* SEL = (LAS u64*)(lds + 137216);
    LAS u64* WUN = (LAS u64*)(lds + 138240);
    LAS float* imp_row = IMP + (wave * 8 + c.qi) * 132;
    const bf16* gn = (const bf16*)(ws + WS_GNSA) + tokrow * 64 + head * 3;
    const float g0 = sigmoidf_(bf2f(gn[0])), g1 = sigmoidf_(bf2f(gn[1])), g2 = sigmoidf_(bf2f(gn[2]));
    f32x16 O[2];
#pragma unroll
    for (int i = 0; i < 16; ++i) { O[0][i] = 0.f; O[1][i] = 0.f; }
    LAS float* ypark = (LAS float*)(lds + 71680 + wave * 8192) + lane;
    float m, l, carry = 0.f;
    if (!(dry & 2)) {
    const int nT = (4 * qb + 2) / 64 + 1;
    const u64 cm = (nT >= 64) ? ~0ull : ((1ull << nT) - 1ull);
    const bf16* Kc = (const bf16*)(ws + WS_KCC) + (size_t)(g * 8 + b) * 512 * 64;
    const bf16* Vc = (const bf16*)(ws + WS_VCT) + (size_t)(g * 8 + b) * 512;
    m = -INFINITY; l = 0.f;
    attn_tiles<0, DV>(wv, lds, Kc, 64, 64 * 64, Vc, 16384, 64, cm, 0ull, c, qb, m, l, O, 0.f, 0.f, imp_row, carry);
    {
        const float m_fin = (m == -INFINITY) ? 0.f : m, inv_l = 1.f / fmaxf(l, 1e-30f);
#pragma unroll
        for (int i = 0; i < 16; ++i) { O[0][i] = 0.f; O[1][i] = 0.f; }
        carry = 0.f;
        attn_tiles<1, DV>(wv, lds, Kc, 64, 64 * 64, Vc, 16384, 64, cm, 0ull, c, qb, m, l, O, m_fin, inv_l, imp_row, carry);
    }
    }
    __syncthreads();
    if (!(dry & 4)) {
        const int qi2 = lane >> 3, l8 = lane & 7;
        const LAS float* irow = IMP + (wave * 8 + qi2) * 132;
        u64 slo = 0ull, shi = 0ull;
        if (qb + 1 <= 16) { slo = (1ull << (qb + 1)) - 1ull; }
        else {
            float sc[16]; unsigned selm = 0u;
#pragma unroll
            for (int i = 0; i < 16; ++i) { const int jj = l8 + 8 * i; const bool forced = (jj == 0 || jj == qb || jj == qb - 1);
                const bool cand = (jj <= qb) && !forced; sc[i] = cand ? irow[jj] : -1.f; if (forced) selm |= 1u << i; }
            for (int round = 0; round < 13; ++round) {
                float lm = sc[0];
#pragma unroll
                for (int i = 1; i < 16; ++i) lm = fmaxf(lm, sc[i]);
                lm = fmaxf(lm, dpp_f<0xB1>(lm)); lm = fmaxf(lm, dpp_f<0x4E>(lm)); lm = fmaxf(lm, dpp_f<0x141>(lm));
                int li = 99;
#pragma unroll
                for (int i = 15; i >= 0; --i) li = (sc[i] == lm) ? i : li;
                int cj = (li < 16) ? (l8 + 8 * li) : 999;
                cj = min(cj, dpp_i<0xB1>(cj)); cj = min(cj, dpp_i<0x4E>(cj)); cj = min(cj, dpp_i<0x141>(cj));
                const int tt = cj - l8;
#pragma unroll
                for (int i = 0; i < 16; ++i) { const bool hit = (tt == 8 * i); sc[i] = hit ? -1.f : sc[i]; selm |= hit ? (1u << i) : 0u; }
            }
#pragma unroll
            for (int i = 0; i < 16; ++i) { if ((selm >> i) & 1u) { if (i < 8) slo |= 1ull << (l8 + 8 * i); else shi |= 1ull << (l8 + 8 * (i - 8)); } }
        }
        unsigned w0 = (unsigned)slo, w1 = (unsigned)(slo >> 32), w2 = (unsigned)shi, w3 = (unsigned)(shi >> 32);
#pragma unroll
        for (int o = 1; o < 8; o <<= 1) { w0 |= __shfl_xor(w0, o); w1 |= __shfl_xor(w1, o); w2 |= __shfl_xor(w2, o); w3 |= __shfl_xor(w3, o); }
        if (l8 == 0) { SEL[(wave * 8 + qi2) * 2] = ((u64)w1 << 32) | w0; SEL[(wave * 8 + qi2) * 2 + 1] = ((u64)w3 << 32) | w2; }
#pragma unroll
        for (int o = 8; o < 64; o <<= 1) { w0 |= __shfl_xor(w0, o); w1 |= __shfl_xor(w1, o); w2 |= __shfl_xor(w2, o); w3 |= __shfl_xor(w3, o); }
        if (lane == 0) { WUN[wave * 2] = ((u64)w1 << 32) | w0; WUN[wave * 2 + 1] = ((u64)w3 << 32) | w2; }
        c.wun_lo = ((u64)w1 << 32) | w0; c.wun_hi = ((u64)w3 << 32) | w2;
    }
    __syncthreads();
    u64 bun_lo = 0ull, bun_hi = 0ull;
#pragma unroll
    for (int w = 0; w < 8; ++w) { bun_lo |= WUN[w * 2]; bun_hi |= WUN[w * 2 + 1]; }
    c.sel_lo = SEL[(wave * 8 + c.qi) * 2]; c.sel_hi = SEL[(wave * 8 + c.qi) * 2 + 1];
#pragma unroll
    for (int i = 0; i < 16; ++i) { ypark[i * 64] = g0 * O[0][i]; ypark[(16 + i) * 64] = g0 * O[1][i]; }
    if (!(dry & 8)) {
        const bf16* Ks = (const bf16*)(ws + WS_KSL) + (size_t)b * SEQ * 256 + g * 64;
        const bf16* Vs = (const bf16*)(ws + WS_VTSL) + (size_t)(g * 64) * MTOK + (size_t)b * SEQ;
        m = -INFINITY; l = 0.f;
#pragma unroll
        for (int i = 0; i < 16; ++i) { O[0][i] = 0.f; O[1][i] = 0.f; }
        attn_tiles<2, DV>(wv, lds, Ks, 256, 64 * 256, Vs, MTOK, 64, bun_lo, bun_hi, c, qb, m, l, O, 0.f, 0.f, imp_row, carry);
        const float sc = g1 / fmaxf(l, 1e-30f);
#pragma unroll
        for (int i = 0; i < 16; ++i) { ypark[i * 64] += sc * O[0][i]; ypark[(16 + i) * 64] += sc * O[1][i]; }
    }
    if (!(dry & 16)) {
        const bf16* Kw = (const bf16*)(ws + WS_KW) + (size_t)b * SEQ * 256 + g * 64;
        const bf16* Vw = (const bf16*)(ws + WS_VTW) + (size_t)(g * 64) * MTOK + (size_t)b * SEQ;
        const int jlo = qb >= 8 ? qb - 8 : 0;
        u64 wlo = 0ull, whi = 0ull;
        for (int jj = jlo; jj <= qb; ++jj) { if (jj < 64) wlo |= 1ull << jj; else whi |= 1ull << (jj - 64); }
        m = -INFINITY; l = 0.f;
#pragma unroll
        for (int i = 0; i < 16; ++i) { O[0][i] = 0.f; O[1][i] = 0.f; }
        attn_tiles<3, DV>(wv, lds, Kw, 256, 64 * 256, Vw, MTOK, 64, wlo, whi, c, qb, m, l, O, 0.f, 0.f, imp_row, carry);
        const float sc = g2 / fmaxf(l, 1e-30f);
#pragma unroll
        for (int i = 0; i < 16; ++i) { O[0][i] = ypark[i * 64] + sc * O[0][i]; O[1][i] = ypark[(16 + i) * 64] + sc * O[1][i]; }
    }
    if (!(dry & 32))
    {
        bf16* Yb = (bf16*)A.out; const bf16* GMA = (const bf16*)(ws + WS_GMA);
#pragma unroll
        for (int mt = 0; mt < 2; ++mt)
#pragma unroll
            for (int v = 0; v < 4; ++v) {
                const size_t idx = tokrow * DM + head * 64 + mt * 32 + 8 * v + 4 * c.h;
                const u32x2 yr = *(const u32x2*)(Yb + idx), gm = *(const u32x2*)(GMA + idx), ct = *(const u32x2*)((const bf16*)(ws + WS_CT) + idx);
                const f32x4 cr = *(const f32x4*)((const float*)(ws + WS_CARRY) + ((size_t)b * 64 + (c.t >> 7)) * DM + head * 64 + mt * 32 + 8 * v + 4 * c.h);
                const float o0 = bflo(yr.x) + bflo(ct.x) * cr[0] + sigmoidf_(bflo(gm.x)) * O[mt][4 * v], o1 = bfhi(yr.x) + bfhi(ct.x) * cr[1] + sigmoidf_(bfhi(gm.x)) * O[mt][4 * v + 1];
                const float o2 = bflo(yr.y) + bflo(ct.y) * cr[2] + sigmoidf_(bflo(gm.y)) * O[mt][4 * v + 2], o3 = bfhi(yr.y) + bfhi(ct.y) * cr[3] + sigmoidf_(bfhi(gm.y)) * O[mt][4 * v + 3];
                *(u32x2*)(((dry & 1) ? (bf16*)(ws + 832 * MiB) : Yb) + idx) = (u32x2){pk2(o0, o1), pk2(o2, o3)};
            }
    }
}

template <bool NORM2>
DI void row_phase(const int wv, const bf16* RAW, const float* base, bf16* XB, bf16* NB, const float* g1, const float* g2, int G) {
    const int tid = TIDX, lane = tid & 63, wave = wv;
    const int gw = blockIdx.x * NWAVES + wave, NGW = G * NWAVES;
    constexpr int R = 4;
    for (int row0 = gw; row0 < MTOK; row0 += R * NGW) {
        float v[R][16], x[R][16];
#pragma unroll
        for (int r = 0; r < R; ++r) {
            const int row = (row0 + r * NGW < MTOK) ? row0 + r * NGW : row0;
#pragma unroll
            for (int jj = 0; jj < 2; ++jj) {
                const size_t off = (size_t)row * DM + 8 * lane + 512 * jj;
                const u32x4 rw = *(const u32x4*)(RAW + off);
                v[r][8 * jj + 0] = bflo(rw.x); v[r][8 * jj + 1] = bfhi(rw.x); v[r][8 * jj + 2] = bflo(rw.y); v[r][8 * jj + 3] = bfhi(rw.y);
                v[r][8 * jj + 4] = bflo(rw.z); v[r][8 * jj + 5] = bfhi(rw.z); v[r][8 * jj + 6] = bflo(rw.w); v[r][8 * jj + 7] = bfhi(rw.w);
                if (NORM2) {
                    const f32x4 x0 = *(const f32x4*)(base + off), x1 = *(const f32x4*)(base + off + 4);
                    x[r][8 * jj + 0] = x0[0]; x[r][8 * jj + 1] = x0[1]; x[r][8 * jj + 2] = x0[2]; x[r][8 * jj + 3] = x0[3]; x[r][8 * jj + 4] = x1[0]; x[r][8 * jj + 5] = x1[1]; x[r][8 * jj + 6] = x1[2]; x[r][8 * jj + 7] = x1[3];
                } else {
                    const u32x4 xw = *(const u32x4*)(XB + off);
                    x[r][8 * jj + 0] = bflo(xw.x); x[r][8 * jj + 1] = bfhi(xw.x); x[r][8 * jj + 2] = bflo(xw.y); x[r][8 * jj + 3] = bfhi(xw.y);
                    x[r][8 * jj + 4] = bflo(xw.z); x[r][8 * jj + 5] = bfhi(xw.z); x[r][8 * jj + 6] = bflo(xw.w); x[r][8 * jj + 7] = bfhi(xw.w);
                }
            }
        }
        float ga[16], gb[16];
#pragma unroll
        for (int jj = 0; jj < 2; ++jj)
#pragma unroll
            for (int i = 0; i < 8; ++i) { ga[8 * jj + i] = g1[8 * lane + 512 * jj + i]; gb[8 * jj + i] = NORM2 ? g2[8 * lane + 512 * jj + i] : 1.f; }
#pragma unroll
        for (int r = 0; r < R; ++r) {
            const int row = row0 + r * NGW;
            float ss = 0.f;
#pragma unroll
            for (int i = 0; i < 16; ++i) ss += v[r][i] * v[r][i];
            const float rs = rsqrtf(wave_sum(ss) * (1.f / DM) + NORM_EPS);
            float ss2 = 0.f;
#pragma unroll
            for (int i = 0; i < 16; ++i) { const float o = x[r][i] + v[r][i] * rs * ga[i]; x[r][i] = o; ss2 += o * o; }
            float rs2 = 1.f;
            if (NORM2) rs2 = rsqrtf(wave_sum(ss2) * (1.f / DM) + NORM_EPS);
            if (row < MTOK) {
#pragma unroll
                for (int jj = 0; jj < 2; ++jj) {
                    const size_t off = (size_t)row * DM + 8 * lane + 512 * jj;
                    const float* xx = &x[r][8 * jj];
                    const u32x4 xw = (u32x4){pk2(xx[0], xx[1]), pk2(xx[2], xx[3]), pk2(xx[4], xx[5]), pk2(xx[6], xx[7])};
                    if (NORM2) {
                        *(u32x4*)(XB + off) = xw;
                        float y[8];
#pragma unroll
                        for (int i = 0; i < 8; ++i) y[i] = xx[i] * rs2 * gb[8 * jj + i];
                        *(u32x4*)(NB + off) = (u32x4){pk2(y[0], y[1]), pk2(y[2], y[3]), pk2(y[4], y[5]), pk2(y[6], y[7])};
                    } else {
                        *(u32x4*)(NB + off) = xw;
                    }
                }
            }
        }
    }
}

__global__ void __launch_bounds__(NTHR, 2) hybrid_fwd(Args args) {
    extern __shared__ __attribute__((aligned(16))) unsigned char lds_raw[];
    LAS unsigned char* lds = (LAS unsigned char*)lds_raw;
    const int G = gridDim.x, bx = blockIdx.x;
    const int wv = __builtin_amdgcn_readfirstlane(threadIdx.x >> 6);
    unsigned char* ws = args.ws; unsigned char* dout = (unsigned char*)args.out;
    const int lo = args.ph_lo, hi = args.ph_hi;
#ifndef PHMASK
#define PHMASK 0xFFFF
#endif
#define IN(k) (((PHMASK >> (k)) & 1) && lo <= (k) && (k) < hi)
    volatile LAS unsigned* xst = (volatile LAS unsigned*)(lds + LDS_SLOT + 64);
    unsigned* xbar = (unsigned*)(ws + WS_BAR); unsigned xcc = 0u;
    if (hi - lo > 1) {
        if (wv == 0) { if (lane_id() == 0) { xst[0] = 0u; xst[1] = 0u;
            const __attribute__((address_space(4))) char* ia = (const __attribute__((address_space(4))) char*)__builtin_amdgcn_implicitarg_ptr();
            const unsigned long long p = *(const __attribute__((address_space(4))) unsigned long long*)(ia + 88);
            if (*(const unsigned*)(p + 40) != (unsigned)G) (void)xb_add(&xbar[XB_TMO], 0u); } }
        xcc = xb_xcc_id();
        if (wv == 0) { if (lane_id() == 0) (void)xb_add(&xbar[XB_XCNT(xcc)], 1u); }
        __syncthreads();
    }
#define SEAM(k) do { if (IN(k) && IN((k) + 1)) { xcd_barrier(wv, xbar, xcc, xst); } } while (0)
    using namespace pg8;

    for (int rep = 0; rep < (((PROBE_MASK >> 0) & 1) ? 2 : 1); ++rep) if (IN(0)) { p0_prologue(wv, args, lds, G); }
    SEAM(0);
    for (int rep = 0; rep < (((PROBE_MASK >> 1) & 1) ? 2 : 1); ++rep) if (IN(1)) {
        { GemmD g{(const char*)dout, (const char*)(ws + WS_WIN), DM, DM, DM, 128, 128, 0}; Sched S; S.init(256, 25, G, bx); EpiSec E{ws, dout};
          gemm_phase<EpiSec, true>(wv, lds, g, S, E); }
        { GemmD g{(const char*)(ws + WS_WV), (const char*)dout, DM, DM, DM, 128, 128, 0}; Sched S; S.init(2, 256, G, bx);
          EpiStore<0, 0> E{(bf16*)(ws + WS_VTSL), (size_t)MTOK, nullptr, 512, MTOK};
          gemm_phase<EpiStore<0, 0>, true>(wv, lds, g, S, E); }
    }
    SEAM(1);
    for (int rep = 0; rep < (((PROBE_MASK >> 2) & 1) ? 2 : 1); ++rep) if (IN(2)) {
        float* posbp = (float*)(ws + WS_POSBP) + (size_t)(bx & 255) * 512;
        { const int tid = TIDX; const int cv = (bx + G / 2) % G; const int mat = tid >> 8;
          if (mat == 0 ? (bx < 64) : (cv < 64)) { float t = 0.f; const float* part = (const float*)(ws + WS_PART) + tid;
              for (int it = 0; it < 256; ++it) t += part[it * 512];
              posbp[tid] = t; }
          asm volatile("s_waitcnt vmcnt(0)" ::: "memory"); __syncthreads(); }
        { GemmD g{(const char*)(ws + WS_KC), (const char*)(ws + WS_CW1K), 2048, 16 * 256, 2048, 512, 128, 1}; Sched S; S.init(64, 1, G, bx);
          EpiStore<1, 0> E{(bf16*)(ws + WS_HIDK), 256, posbp, 16384, 256};
          gemm_phase<EpiStore<1, 0>, false>(wv, lds, g, S, E); }
        { GemmD g{(const char*)(ws + WS_VC), (const char*)(ws + WS_CW1V), 2048, 16 * 256, 2048, 512, 128, 1}; Sched S; S.init(64, 1, G, (bx + G / 2) % G);
          EpiStore<1, 0> E{(bf16*)(ws + WS_HIDV), 256, posbp + 256, 16384, 256};
          gemm_phase<EpiStore<1, 0>, false>(wv, lds, g, S, E); }
        { GemmD g{(const char*)(ws + WS_HIDK), (const char*)(ws + WS_CW2K), 256, 256, 256, 128, 128, 0}; Sched S; S.init(64, 1, G, bx);
          EpiStore<0, 1> E{(bf16*)(ws + WS_KCC), 64, nullptr, 16384, 64};
          gemm_phase<EpiStore<0, 1>, false>(wv, lds, g, S, E); }
        { GemmD g{(const char*)(ws + WS_CW2V), (const char*)(ws + WS_HIDV), 256, 256, 256, 128, 128, 0}; Sched S; S.init(1, 64, G, (bx + G / 2) % G);
          EpiStore<0, 2> E{(bf16*)(ws + WS_VCT), 16384, nullptr, 64, 16384};
          gemm_phase<EpiStore<0, 2>, false>(wv, lds, g, S, E); }
        __syncthreads();
        for (;;) { const int it = next_item(wv, lds, (unsigned*)(ws + WS_CTR) + 64 * rep); if (it >= 1024) break; scan_item<2>(wv, args, lds, it); }
    }
    SEAM(2);
    for (int rep = 0; rep < (((PROBE_MASK >> 3) & 1) ? 2 : 1); ++rep) if (IN(3)) {
        __syncthreads();
        {
            const int gt = bx * NTHR + TIDX;
            if (gt < NB * DM) { const int b = gt >> 10, ch = gt & 1023; const float2* AG = (const float2*)(ws + WS_AGG2) + (size_t)b * 64 * DM + ch; float* CR = (float*)(ws + WS_CARRY) + (size_t)b * 64 * DM + ch;
                float2 agv[64];
#pragma unroll
                for (int i = 0; i < 64; ++i) agv[i] = AG[(size_t)i * DM];
                float hc = 0.f;
#pragma unroll
                for (int i = 0; i < 64; ++i) { CR[(size_t)i * DM] = hc; hc = agv[i].x * hc + agv[i].y; } }
        }
    }
    SEAM(3);
    if (IN(4)) {
        if (wv >= 4) __builtin_amdgcn_s_setprio(1);
#if (PROBE_MASK >> 4) & 1
        for (int it = bx; it < 4096; it += G) { const int qb = 127 - (it >> 5), bg = it & 31; attn_unit<DRYV>(wv, args, lds, bg >> 2, bg & 3, qb, DRYMODE); }
#endif
        {
            const unsigned myx = xb_xcc_id() & 7u;
            for (unsigned dx = 0; dx < 8; ++dx) {
                const unsigned qx = (myx + dx) & 7u;
                unsigned* qctr = (unsigned*)(ws + WS_CTR) + 256 + 16 * qx;
                for (;;) {
                    const int it = next_item(wv, lds, qctr); if (it >= 512) break;
                    const int qb = 127 - (it >> 2), g = it & 3, b = (int)((qx + (unsigned)g) & 7u);
                    attn_unit<0>(wv, args, lds, b, g, qb, 0);
                }
            }
        }
        __builtin_amdgcn_s_setprio(0);
        __syncthreads();
    }
    SEAM(4);
    for (int rep = 0; rep < (((PROBE_MASK >> 5) & 1) ? 2 : 1); ++rep) if (IN(5)) {
        GemmD g{(const char*)dout, (const char*)(ws + WS_WOUT), DM, DM, DM, 128, 128, 0}; Sched S; S.init(256, 4, G, bx);
        EpiStore<0, 0> E{(bf16*)(ws + WS_RAW), DM, nullptr, MTOK, DM};
        gemm_phase<EpiStore<0, 0>, true>(wv, lds, g, S, E);
    }
    SEAM(5);
    for (int rep = 0; rep < (((PROBE_MASK >> 6) & 1) ? 2 : 1); ++rep) if (IN(6)) {
        row_phase<true>(wv, (const bf16*)(ws + WS_RAW), args.in[0], (bf16*)args.out, (bf16*)(ws + WS_H2), args.in[3], args.in[19], G);
        const float* p = args.in[1]; bf16* pb = (bf16*)(ws + WS_PB);
        for (size_t i = ((size_t)bx * NTHR + TIDX) * 8; i < (size_t)MTOK * DPLE; i += (size_t)G * NTHR * 8) {
            const f32x4 a = *(const f32x4*)(p + i), b2 = *(const f32x4*)(p + i + 4);
            *(u32x4*)(pb + i) = (u32x4){pk2(a[0], a[1]), pk2(a[2], a[3]), pk2(b2[0], b2[1]), pk2(b2[2], b2[3])};
        }
    }
    SEAM(6);
    for (int rep = 0; rep < (((PROBE_MASK >> 7) & 1) ? 2 : 1); ++rep) if (IN(7)) {
        { GemmD g{(const char*)(ws + WS_H2), (const char*)(ws + WS_WGU), DM, DM, DM, 128, 128, 0}; Sched S; S.init(256, 22, G, bx); EpiSwi E{(bf16*)(ws + WS_ACT)};
          gemm_phase<EpiSwi, true>(wv, lds, g, S, E); }
        { GemmD g{(const char*)(ws + WS_PB), (const char*)(ws + WS_WPP), DPLE, DPLE, DPLE, 128, 128, 0}; Sched S; S.init(256, 4, G, bx);
          EpiStore<0, 0> E{(bf16*)(ws + WS_PP), DM, nullptr, MTOK, DM};
          gemm_phase<EpiStore<0, 0>, true>(wv, lds, g, S, E); }
    }
    SEAM(7);
    for (int rep = 0; rep < (((PROBE_MASK >> 8) & 1) ? 2 : 1); ++rep) if (IN(8)) {
        GemmD g{(const char*)(ws + WS_ACT), (const char*)(ws + WS_WDN), DFF, DFF, DFF, 128, 128, 0}; Sched S; S.init(256, 4, G, bx);
        EpiStore<0, 0> E{(bf16*)(ws + WS_RAW), DM, nullptr, MTOK, DM};
        gemm_phase<EpiStore<0, 0>, true>(wv, lds, g, S, E);
    }
    SEAM(8);
    if (IN(9)) {
        row_phase<false>(wv, (const bf16*)(ws + WS_RAW), nullptr, (bf16*)args.out, (bf16*)(ws + WS_H2), args.in[20], nullptr, G);
    }
    SEAM(9);
    if (IN(10)) {
        GemmD g{(const char*)(ws + WS_H2), (const char*)(ws + WS_WPG), DM, DM, DM, 128, 128, 0}; Sched S; S.init(256, 4, G, bx);
        EpiPle E{args.out, (const bf16*)(ws + WS_H2), (const bf16*)(ws + WS_PP), args.in[25]};
        gemm_phase<EpiPle, true>(wv, lds, g, S, E);
    }
#undef IN
#undef SEAM
}

constexpr int NPHASE = 11;
#ifndef ONE_LAUNCH
#define ONE_LAUNCH 1
#endif

extern "C" void kernel_launch(void* const* d_in, const int* in_sizes, int n_in, void* d_out, int out_size, void* d_ws, size_t ws_size, hipStream_t stream) {
    static int grid = 0;
    if (grid == 0) {
        if (n_in != 26 || out_size != MTOK * DM || ws_size < WS_END) { fprintf(stderr, "kernel_launch: unexpected problem shape (n_in %d out %d ws %zu)\n", n_in, out_size, ws_size); grid = -1; return; }
        int dev = 0, cus = 0, per_cu = 0;
        hipGetDevice(&dev); hipDeviceGetAttribute(&cus, hipDeviceAttributeMultiprocessorCount, dev);
        hipFuncSetAttribute((const void*)hybrid_fwd, hipFuncAttributeMaxDynamicSharedMemorySize, LDS_BYTES);
        if (hipOccupancyMaxActiveBlocksPerMultiprocessor(&per_cu, (const void*)hybrid_fwd, NTHR, LDS_BYTES) != hipSuccess || per_cu < 1) per_cu = 1;
        (void)hipGetLastError();
        grid = cus * 1;
    }
    if (grid <= 0) return;
    Args a{};
    for (int i = 0; i < 26; ++i) a.in[i] = (const float*)d_in[i];
    a.out = (float*)d_out; a.ws = (unsigned char*)d_ws;
    (void)hipMemsetAsync((unsigned char*)d_ws + WS_CTR, 0, CTL_BYTES, stream);
#if ONE_LAUNCH
    a.ph_lo = 0; a.ph_hi = NPHASE;
    void* kargs[] = {&a};
    hipError_t e = hipLaunchCooperativeKernel((const void*)hybrid_fwd, dim3(grid), dim3(NTHR), kargs, LDS_BYTES, stream);
    if (e != hipSuccess) fprintf(stderr, "cooperative launch failed: %s (grid %d)\n", hipGetErrorString(e), grid);
#else
    for (int ph = 0; ph < NPHASE; ++ph) { a.ph_lo = ph; a.ph_hi = ph + 1; hipLaunchKernelGGL(hybrid_fwd, dim3(grid), dim3(NTHR), LDS_BYTES, stream, a); }
#endif
}
```

```cpp
#include <hip/hip_runtime.h>
#include <hip/hip_cooperative_groups.h>
#include <cstdio>
#include <cstdint>
namespace cg = cooperative_groups;
#ifndef DRYV
#define DRYV 0
#endif
#ifndef DRYMODE
#define DRYMODE 1
#endif
#ifndef PROBE_MASK
#define PROBE_MASK 0x0
#endif

#define LAS __attribute__((address_space(3)))
#define DI __device__ __forceinline__
typedef unsigned short bf16;
typedef short bf16x8 __attribute__((ext_vector_type(8)));
typedef short s16x4 __attribute__((ext_vector_type(4)));
typedef float f32x4 __attribute__((ext_vector_type(4)));
typedef float f32x16 __attribute__((ext_vector_type(16)));
typedef unsigned u32x4 __attribute__((ext_vector_type(4)));
typedef unsigned u32x2 __attribute__((ext_vector_type(2)));
typedef unsigned long long u64;

constexpr int NB = 8, SEQ = 8192, DM = 1024, MTOK = NB * SEQ, DFF = 2816, DPLE = 256, DIN = 6704;
constexpr int NWAVES = 8, NTHR = 512;
constexpr float NORM_EPS = 1e-6f;
constexpr float LOG2E = 1.4426950408889634f;

constexpr size_t MiB = (size_t)1 << 20, KiB = 1024;
constexpr size_t WS_WIN = 0;
constexpr size_t WS_WV = WS_WIN + (size_t)6400 * 2048;
constexpr size_t WS_WOUT = 14 * MiB, WS_WGU = 16 * MiB, WS_WDN = 27 * MiB, WS_WPG = 33 * MiB, WS_WPP = 35 * MiB;
constexpr size_t WS_CW1K = 36 * MiB, WS_CW1V = 37 * MiB, WS_CW2K = 38 * MiB, WS_CW2V = 38 * MiB + 128 * KiB;
constexpr size_t WS_LWA = 38 * MiB + 256 * KiB, WS_LWX = 38 * MiB + 384 * KiB, WS_POSB = 38 * MiB + 512 * KiB;
constexpr size_t WS_PART = 63 * MiB, WS_POSBP = 63 * MiB + 512 * KiB;
constexpr size_t WS_CTR = 38 * MiB + 768 * KiB, WS_BAR = WS_CTR + 16 * KiB, CTL_BYTES = 32 * KiB;
constexpr size_t WS_AGG = 39 * MiB;
constexpr size_t WS_HIDK = 43 * MiB, WS_HIDV = 51 * MiB;
constexpr size_t WS_KCC = 59 * MiB, WS_VCT = 61 * MiB;
constexpr size_t WS_XR = 64 * MiB, WS_GR = 192 * MiB, WS_Q = 320 * MiB, WS_KC = 448 * MiB, WS_VC = 480 * MiB, WS_KSL = 512 * MiB, WS_KW = 544 * MiB;
constexpr size_t WS_GMA = 576 * MiB, WS_GNSA = 704 * MiB, WS_VTSL = 712 * MiB, WS_VTW = 744 * MiB;
constexpr size_t WS_RAW = 64 * MiB, WS_H2 = 192 * MiB, WS_ACT = 320 * MiB, WS_PB = 672 * MiB, WS_PP = 704 * MiB;
constexpr size_t WS_CT = 832 * MiB;
constexpr size_t WS_CARRY = 39 * MiB;
constexpr size_t WS_AGG2 = 960 * MiB;
constexpr size_t WS_END = 964 * MiB;

constexpr int LDS_BYTES = 163840;

typedef __bf16 bf16x2_t __attribute__((ext_vector_type(2)));
typedef float f32x2_t __attribute__((ext_vector_type(2)));
DI unsigned pk2(float lo, float hi) { const f32x2_t v = {lo, hi}; const bf16x2_t b = __builtin_convertvector(v, bf16x2_t); return __builtin_bit_cast(unsigned, b); }
DI unsigned f2bf(float f) { return pk2(f, 0.f) & 0xffffu; }
DI float bf2f(unsigned b) { return __builtin_bit_cast(float, b << 16); }
DI float bflo(unsigned w) { return __builtin_bit_cast(float, w << 16); }
DI float bfhi(unsigned w) { return __builtin_bit_cast(float, w & 0xffff0000u); }
DI float sigmoidf_(float x) { return __builtin_amdgcn_rcpf(1.f + __builtin_amdgcn_exp2f(fminf(-x * LOG2E, 126.f))); }
DI float gelu_tanh(float x) { const float u = 0.7978845608028654f * (x + 0.044715f * x * x * x); return x * sigmoidf_(2.f * u); }
template <int CTRL> DI float dpp_f(float x) { return __builtin_bit_cast(float, __builtin_amdgcn_update_dpp(0, __builtin_bit_cast(int, x), CTRL, 0xF, 0xF, true)); }
template <int CTRL> DI int dpp_i(int x) { return __builtin_amdgcn_update_dpp(0, x, CTRL, 0xF, 0xF, true); }
DI float wave_sum(float v) {
#pragma unroll
    for (int o = 1; o < 64; o <<= 1) v += __shfl_xor(v, o);
    return v;
}
DI int lane_id() { int l; asm volatile("v_mbcnt_lo_u32_b32 %0, -1, 0\n\tv_mbcnt_hi_u32_b32 %0, -1, %0" : "=v"(l)); return l; }
#define TIDX (wv * 64 + lane_id())
DI void grid_sync_(const int wv) {
    __builtin_amdgcn_fence(__ATOMIC_RELEASE, "workgroup");
    __builtin_amdgcn_s_barrier();
    if (wv == 0) {
        if (lane_id() == 0) {
            __builtin_amdgcn_fence(__ATOMIC_ACQUIRE, "workgroup");
            __builtin_amdgcn_fence(__ATOMIC_RELEASE, "agent");
            const __attribute__((address_space(4))) char* ia = (const __attribute__((address_space(4))) char*)__builtin_amdgcn_implicitarg_ptr();
            const unsigned long long p = *(const __attribute__((address_space(4))) unsigned long long*)(ia + 88);
            unsigned* cnt = (unsigned*)(p + 32);
            const unsigned n = *(const unsigned*)(p + 40);
            const unsigned v = __hip_atomic_fetch_add(cnt, 1u, __ATOMIC_RELAXED, __HIP_MEMORY_SCOPE_AGENT);
            if ((v & 0xffffu) == n - 1u) (void)__hip_atomic_fetch_add(cnt, 65536u - n, __ATOMIC_RELAXED, __HIP_MEMORY_SCOPE_AGENT);
            const unsigned gen = v & 0xffff0000u;
            while ((__hip_atomic_load(cnt, __ATOMIC_RELAXED, __HIP_MEMORY_SCOPE_AGENT) & 0xffff0000u) == gen) __builtin_amdgcn_s_sleep(1);
            __builtin_amdgcn_fence(__ATOMIC_ACQUIRE, "agent");
            __builtin_amdgcn_fence(__ATOMIC_RELEASE, "workgroup");
        }
    }
    __builtin_amdgcn_s_barrier();
    __builtin_amdgcn_fence(__ATOMIC_ACQUIRE, "workgroup");
}
constexpr int LDS_SLOT = 155648;
DI int next_item(const int wv, LAS unsigned char* lds, unsigned* ctr) {
    __syncthreads();
    if (wv == 0) { if (lane_id() == 0) *(volatile LAS int*)(lds + LDS_SLOT) = (int)__hip_atomic_fetch_add(ctr, 1u, __ATOMIC_RELAXED, __HIP_MEMORY_SCOPE_AGENT); }
    __syncthreads();
    return *(volatile LAS int*)(lds + LDS_SLOT);
}

#define XB_TMO      128
#define XB_XCNT(j)  (256  + 64 * (j))
#define XB_XSUB(j)  (1280 + 64 * (j))
#define XB_XGEN(j)  (2304 + 64 * (j))
#define XB_TOP      3328
#define XB_TOPGEN   3392
#define XCD_BAR_WORDS 3456
#define XB_SPIN_CAP (1u << 22)
DI unsigned xb_ld(unsigned* p)              { return __hip_atomic_load(p, __ATOMIC_RELAXED, __HIP_MEMORY_SCOPE_AGENT); }
DI unsigned xb_add(unsigned* p, unsigned v) { return __hip_atomic_fetch_add(p, v, __ATOMIC_RELAXED, __HIP_MEMORY_SCOPE_AGENT); }
DI unsigned xb_xcc_id() { return (unsigned)__builtin_amdgcn_s_getreg((3 << 11) | 20) & 0xFu; }
#define XB_SPIN(cond, bar) do { unsigned _sp = 0; while (cond) { __builtin_amdgcn_s_sleep(1); \
    if ((++_sp & 255u) == 0u) { if (xb_ld(&(bar)[XB_TMO])) break; if (_sp > XB_SPIN_CAP) { atomicAdd(&(bar)[XB_TMO], 1u); break; } } } } while (0)
DI void xcd_barrier_complete(unsigned* bar, unsigned x, unsigned& nloc, unsigned& nx) {
    const unsigned G = gridDim.x * gridDim.y * gridDim.z;
    unsigned sum, cnt, mine, sp = 0u;
    for (;;) {
        sum = 0u; cnt = 0u; mine = 0u;
#pragma unroll
        for (unsigned j = 0; j < 16; ++j) { const unsigned c = xb_ld(&bar[XB_XCNT(j)]); sum += c; cnt += (c > 0u) ? 1u : 0u; mine = (j == x) ? c : mine; }
        if (sum == G) break;
        __builtin_amdgcn_s_sleep(1);
        if ((++sp & 255u) == 0u) { if (xb_ld(&bar[XB_TMO])) break; if (sp > XB_SPIN_CAP) { atomicAdd(&bar[XB_TMO], 1u); break; } }
    }
    nloc = mine > 0u ? mine : 1u; nx = cnt > 0u ? cnt : 1u;
}
DI void xcd_barrier(const int wv, unsigned* bar, const unsigned x, volatile LAS unsigned* st) {
    asm volatile("s_waitcnt vmcnt(0)" ::: "memory");
    __syncthreads();
    if (wv == 0) { if (lane_id() == 0) {
        __builtin_amdgcn_s_waitcnt(0);
        unsigned nloc = st[0], nx = st[1];
        if (nloc == 0u) { xcd_barrier_complete(bar, x, nloc, nx); st[0] = nloc; st[1] = nx; }
        const unsigned old = xb_add(&bar[XB_XSUB(x)], 1u);
        const unsigned gen = old / nloc;
        if (old + 1u == (gen + 1u) * nloc) {
            __builtin_amdgcn_fence(__ATOMIC_RELEASE, "agent");
            asm volatile("s_waitcnt vmcnt(0)" ::: "memory");
            const unsigned og = xb_add(&bar[XB_TOP], 1u);
            const unsigned tg = og / nx;
            if (og + 1u == (tg + 1u) * nx) xb_add(&bar[XB_TOPGEN], 1u);
            else XB_SPIN(xb_ld(&bar[XB_TOPGEN]) == tg, bar);
            __builtin_amdgcn_fence(__ATOMIC_ACQUIRE, "agent");
            xb_add(&bar[XB_XGEN(x)], 1u);
            asm volatile("s_waitcnt vmcnt(0)" ::: "memory");
        } else {
            XB_SPIN(xb_ld(&bar[XB_XGEN(x)]) == gen, bar);
            __builtin_amdgcn_fence(__ATOMIC_ACQUIRE, "agent");
            asm volatile("s_waitcnt vmcnt(0)" ::: "memory");
        }
    } }
    __syncthreads();
}
#define LDS_WAIT() asm volatile("s_waitcnt lgkmcnt(0)" ::: "memory")

namespace pg8 {
constexpr int BM = 256, BK = 64, HALF = 128, HTB = HALF * BK * 2, NXCD = 8, WGM = 8;
DI int lds_byte(int r, int c) { const int st = (r >> 4) * 2 + (c >> 5), rr = r & 15, cc = c & 31, ob = rr * 64 + cc * 2; return st * 1024 + (ob ^ (((ob >> 9) & 1) << 5)); }
DI void stage_rc(int b, int& R, int& C) { const int st = b / 1024, sb = b % 1024, swz = sb ^ (((sb >> 9) & 1) << 5); R = (st >> 1) * 16 + swz / 64; C = (st & 1) * 32 + (swz % 64) / 2; }
DI int perm32(int rho) { const int n = rho >> 4, i = rho & 15; return 8 * (i >> 2) + 4 * n + (i & 3); }
struct Unit { int pm, pn; };
struct Sched {
    int nM, nN, nwg, G, c;
    DI void init(int nM_, int nN_, int G_, int c_) { nM = nM_; nN = nN_; nwg = nM * nN; G = G_; c = c_; }
    DI bool next(int i, Unit& u) const {
        const long L = (long)i * G + c; if (L >= nwg) return false;
        int wgid = (int)L; { const int q = nwg / NXCD, r = nwg % NXCD, xcd = wgid % NXCD, off = wgid / NXCD; wgid = (xcd < r ? xcd * (q + 1) : r * (q + 1) + (xcd - r) * q) + off; }
        const int nig = WGM * nN, gid = wgid / nig, fm = gid * WGM, gsz = (nM - fm) < WGM ? (nM - fm) : WGM;
        u.pm = fm + ((wgid % nig) % gsz); u.pn = (wgid % nig) / gsz; return true;
    }
};
struct GemmD {
    const char* A; const char* Bt; int K; unsigned lda, ldb, kstepA, kstepB; int amode;
    DI const char* a(const Unit& u) const {
        if (amode == 1) return A + (((size_t)(u.pm & 15) * 256 * 16 * 256) + (size_t)(u.pm >> 4) * 64) * 2;
        return A + (size_t)u.pm * 256 * lda * 2;
    }
    DI const char* b(const Unit& u) const { return Bt + (size_t)u.pn * 256 * ldb * 2; }
};

template <class Epi, bool ALIGN_EPI>
DI void gemm_phase(const int wv, LAS unsigned char* lds, const GemmD g, const Sched& S, const Epi& E) {
    const int tid = TIDX, wid = wv, lane = tid & 63, wr = wid >> 2, wc = wid & 3, fr = lane & 15, fq = lane >> 4;
    const int nt = g.K / BK;
    unsigned voffA[2], voffB[2];
#pragma unroll
    for (int i = 0; i < 2; ++i) { int R, C; stage_rc(tid * 16 + i * 8192, R, C); const int Rb = (R & ~31) + perm32(R & 31);
        voffA[i] = (unsigned)(R * g.lda + C) * 2u; voffB[i] = (unsigned)(Rb * g.ldb + C) * 2u; }
    const size_t kstepA = g.kstepA, kstepB = g.kstepB;
    const size_t hstepA = (size_t)HALF * g.lda * 2, hstepB = (size_t)HALF * g.ldb * 2;
    const unsigned ldsw = (unsigned)wid * 1024u;
    const int aoff = lds_byte(wr * 64 + fr, fq * 8), boff = lds_byte(wc * 32 + fr, fq * 8);
#define PG8_SA(b, h) (((b) * 2 + (h)) * HTB)
#define PG8_SB(b, h) ((4 + (b) * 2 + (h)) * HTB)
#define PG8_STAGE(bufoff, gbase, voff) do { _Pragma("unroll") for (int _i = 0; _i < 2; ++_i) \
        __builtin_amdgcn_global_load_lds((const unsigned*)((const char*)(gbase) + (voff)[_i]), (LAS unsigned*)(lds + (bufoff) + ldsw + _i * 8192), 16, 0, 0); } while (0)
#define PG8_LDA(dst, b, h) do { _Pragma("unroll") for (int m = 0; m < 4; ++m) _Pragma("unroll") for (int k = 0; k < 2; ++k) dst[m][k] = *(const LAS bf16x8*)(lds + PG8_SA(b, h) + aoff + m * 2048 + k * 1024); } while (0)
#define PG8_LDB(dst, b, h) do { _Pragma("unroll") for (int n = 0; n < 2; ++n) _Pragma("unroll") for (int k = 0; k < 2; ++k) dst[n][k] = *(const LAS bf16x8*)(lds + PG8_SB(b, h) + boff + n * 2048 + k * 1024); } while (0)
#define PG8_MMA(ai, bj, At, Bt) do { __builtin_amdgcn_s_setprio(1); _Pragma("unroll") for (int m = 0; m < 4; ++m) _Pragma("unroll") for (int n = 0; n < 2; ++n) _Pragma("unroll") for (int k = 0; k < 2; ++k) \
        acc[ai][bj][m][n] = __builtin_amdgcn_mfma_f32_16x16x32_bf16(Bt[n][k], At[m][k], acc[ai][bj][m][n], 0, 0, 0); __builtin_amdgcn_s_setprio(0); } while (0)
#define PG8_WAIT_V(n) asm volatile("s_waitcnt vmcnt(" #n ")" ::: "memory")
#define PG8_WAIT_L(n) asm volatile("s_waitcnt lgkmcnt(" #n ")" ::: "memory")
#define PG8_BAR __builtin_amdgcn_s_barrier()
#define PG8_SCHED __builtin_amdgcn_sched_barrier(0)
    Unit cur, nxt; int ui = 0;
    if (!S.next(0, cur)) return;
    f32x4 acc[2][2][4][2];
#pragma unroll
    for (int a = 0; a < 2; ++a)
#pragma unroll
        for (int b = 0; b < 2; ++b)
#pragma unroll
            for (int m = 0; m < 4; ++m)
#pragma unroll
                for (int n = 0; n < 2; ++n) acc[a][b][m][n] = (f32x4){0.f, 0.f, 0.f, 0.f};
    bf16x8 At[4][2], B0[2][2], B1[2][2];
    const char* cA = g.a(cur); const char* cB = g.b(cur);
    PG8_STAGE(PG8_SB(0, 0), cB, voffB); PG8_STAGE(PG8_SB(0, 1), cB + hstepB, voffB); PG8_STAGE(PG8_SA(0, 0), cA, voffA); PG8_STAGE(PG8_SA(0, 1), cA + hstepA, voffA);
    if (wr == 1) PG8_BAR;
    PG8_WAIT_V(2); PG8_BAR;
    PG8_STAGE(PG8_SB(1, 0), cB + kstepB, voffB); PG8_STAGE(PG8_SA(1, 0), cA + kstepA, voffA); PG8_STAGE(PG8_SB(1, 1), cB + hstepB + kstepB, voffB);
    PG8_WAIT_V(6); PG8_BAR;
    for (;;) {
        const bool has_next = S.next(ui + 1, nxt);
        const char* nA = has_next ? g.a(nxt) : cA; const char* nB = has_next ? g.b(nxt) : cB;
        for (int t = 0; t < nt; t += 2) {
            const bool last = (t == nt - 2);
            const char* a1 = cA + (size_t)(t + 1) * kstepA;
            const char* a2 = last ? nA : cA + (size_t)(t + 2) * kstepA; const char* b2 = last ? nB : cB + (size_t)(t + 2) * kstepB;
            const char* a3 = a2 + kstepA; const char* b3 = b2 + kstepB;
            PG8_LDB(B0, 0, 0); PG8_LDB(B1, 0, 1); PG8_SCHED; PG8_LDA(At, 0, 0); PG8_STAGE(PG8_SA(1, 1), a1 + hstepA, voffA);
            PG8_WAIT_V(8); PG8_WAIT_L(0); PG8_BAR; PG8_MMA(0, 0, At, B0); PG8_MMA(0, 1, At, B1); PG8_BAR; PG8_SCHED;
            PG8_LDA(At, 0, 1); PG8_STAGE(PG8_SB(0, 0), b2, voffB); PG8_STAGE(PG8_SB(0, 1), b2 + hstepB, voffB); PG8_STAGE(PG8_SA(0, 0), a2, voffA);
            PG8_WAIT_V(8); PG8_WAIT_L(0); PG8_BAR; PG8_MMA(1, 0, At, B0); PG8_MMA(1, 1, At, B1); PG8_BAR; PG8_SCHED;
            PG8_LDB(B0, 1, 0); PG8_LDB(B1, 1, 1); PG8_SCHED; PG8_LDA(At, 1, 0); PG8_STAGE(PG8_SA(0, 1), a2 + hstepA, voffA);
            PG8_WAIT_V(8); PG8_WAIT_L(0); PG8_BAR; PG8_MMA(0, 0, At, B0); PG8_MMA(0, 1, At, B1); PG8_BAR; PG8_SCHED;
            PG8_LDA(At, 1, 1); PG8_STAGE(PG8_SB(1, 0), b3, voffB); PG8_STAGE(PG8_SB(1, 1), b3 + hstepB, voffB); PG8_STAGE(PG8_SA(1, 0), a3, voffA);
            PG8_WAIT_V(8); PG8_WAIT_L(0); PG8_BAR; PG8_MMA(1, 0, At, B0); PG8_MMA(1, 1, At, B1); PG8_BAR; PG8_SCHED;
        }
        if constexpr (ALIGN_EPI) { if (wr == 0) PG8_BAR; }
        E(acc, cur, wr, wc, fr, fq);
        if (!has_next) break;
#pragma unroll
        for (int a = 0; a < 2; ++a)
#pragma unroll
            for (int b = 0; b < 2; ++b)
#pragma unroll
                for (int m = 0; m < 4; ++m)
#pragma unroll
                    for (int n = 0; n < 2; ++n) acc[a][b][m][n] = (f32x4){0.f, 0.f, 0.f, 0.f};
        cur = nxt; cA = nA; cB = nB; ++ui;
        if constexpr (ALIGN_EPI) { if (wr == 1) PG8_BAR; }
    }
    PG8_WAIT_V(0);
    if constexpr (!ALIGN_EPI) { if (wr == 0) PG8_BAR; }
    PG8_BAR;
#undef PG8_SA
#undef PG8_SB
#undef PG8_STAGE
#undef PG8_LDA
#undef PG8_LDB
#undef PG8_MMA
#undef PG8_WAIT_V
#undef PG8_WAIT_L
#undef PG8_BAR
#undef PG8_SCHED
}

#define EPI_LOOP for (int ai = 0; ai < 2; ++ai) _Pragma("unroll") for (int m = 0; m < 4; ++m) _Pragma("unroll") for (int bj = 0; bj < 2; ++bj)
DI u32x4 pack8(const f32x4 v0, const f32x4 v1) { u32x4 w; w.x = pk2(v0[0], v0[1]); w.y = pk2(v0[2], v0[3]); w.z = pk2(v1[0], v1[1]); w.w = pk2(v1[2], v1[3]); return w; }

template <int ACT, int ZM> struct EpiStore {
    bf16* O; size_t ld; const float* bias; int row_valid, col_valid;
    DI void operator()(const f32x4 (&acc)[2][2][4][2], const Unit& u, int wr, int wc, int fr, int fq) const {
#pragma unroll
        EPI_LOOP {
            const int row = u.pm * 256 + ai * 128 + wr * 64 + m * 16 + fr, col0 = u.pn * 256 + bj * 128 + wc * 32 + 8 * fq;
            if (row < row_valid && col0 < col_valid) {
                f32x4 v0 = acc[ai][bj][m][0], v1 = acc[ai][bj][m][1];
                if (bias) { v0 += *(const f32x4*)(bias + col0); v1 += *(const f32x4*)(bias + col0 + 4); }
                if (ACT == 1) {
#pragma unroll
                    for (int i = 0; i < 4; ++i) { v0[i] = gelu_tanh(v0[i]); v1[i] = gelu_tanh(v1[i]); }
                }
                if (ZM == 1) { if ((row & 511) == 511) { v0 = (f32x4){0.f, 0.f, 0.f, 0.f}; v1 = v0; } }
                if (ZM == 2) { if (((col0 + 7) & 511) == 511) v1[3] = 0.f; }
                *(u32x4*)(O + (size_t)row * ld + col0) = pack8(v0, v1);
            }
        }
    }
};
struct EpiSec {
    unsigned char* ws; unsigned char* dout;
    DI void operator()(const f32x4 (&acc)[2][2][4][2], const Unit& u, int wr, int wc, int fr, int fq) const {
        const int pn = u.pn; bf16* base; int ld, c0, nc = 256;
        if (pn < 12) { base = (bf16*)(ws + WS_XR + (size_t)(pn >> 2) * 128 * MiB); ld = 1024; c0 = (pn & 3) * 256; }
        else if (pn < 16) { base = (bf16*)(ws + WS_KC + (size_t)(pn - 12) * 32 * MiB); ld = 256; c0 = 0; }
        else if (pn < 20) { base = (bf16*)(dout + 128 * MiB); ld = 1024; c0 = (pn - 16) * 256; }
        else if (pn < 24) { base = (bf16*)(ws + WS_GMA); ld = 1024; c0 = (pn - 20) * 256; }
        else { base = (bf16*)(ws + WS_GNSA); ld = 64; c0 = 0; nc = 64; }
        const float qs = (pn >= 8 && pn < 12) ? 0.125f * LOG2E : 1.f;
#pragma unroll
        EPI_LOOP {
            const int row = u.pm * 256 + ai * 128 + wr * 64 + m * 16 + fr, cl = bj * 128 + wc * 32 + 8 * fq;
            if (cl < nc) __builtin_nontemporal_store(pack8(acc[ai][bj][m][0] * qs, acc[ai][bj][m][1] * qs), (u32x4*)(base + (size_t)row * ld + c0 + cl));
        }
    }
};
struct EpiSwi {
    bf16* O;
    DI void operator()(const f32x4 (&acc)[2][2][4][2], const Unit& u, int wr, int wc, int fr, int fq) const {
#pragma unroll
        for (int ai = 0; ai < 2; ++ai)
#pragma unroll
            for (int m = 0; m < 4; ++m) {
                const int row = u.pm * 256 + ai * 128 + wr * 64 + m * 16 + fr, col0 = u.pn * 128 + wc * 32 + 8 * fq;
                f32x4 v0, v1;
#pragma unroll
                for (int i = 0; i < 4; ++i) { const float g0 = acc[ai][0][m][0][i], g1 = acc[ai][0][m][1][i];
                    v0[i] = g0 * sigmoidf_(g0) * acc[ai][1][m][0][i]; v1[i] = g1 * sigmoidf_(g1) * acc[ai][1][m][1][i]; }
                __builtin_nontemporal_store(pack8(v0, v1), (u32x4*)(O + (size_t)row * DFF + col0));
                asm volatile("" ::: "memory");
            }
    }
};
struct EpiPle {
    float* out; const bf16* xb; const bf16* pp; const float* bias;
    DI void operator()(const f32x4 (&acc)[2][2][4][2], const Unit& u, int wr, int wc, int fr, int fq) const {
        f32x4 b0[2], b1[2];
#pragma unroll
        for (int bj = 0; bj < 2; ++bj) { const int col0 = u.pn * 256 + bj * 128 + wc * 32 + 8 * fq; b0[bj] = *(const f32x4*)(bias + col0); b1[bj] = *(const f32x4*)(bias + col0 + 4); }
#pragma unroll
        for (int ai = 0; ai < 2; ++ai) {
            u32x4 pw[4][2], xw[4][2];
#pragma unroll
            for (int m = 0; m < 4; ++m)
#pragma unroll
                for (int bj = 0; bj < 2; ++bj) {
                    const size_t off = (size_t)(u.pm * 256 + ai * 128 + wr * 64 + m * 16 + fr) * DM + u.pn * 256 + bj * 128 + wc * 32 + 8 * fq;
                    pw[m][bj] = *(const u32x4*)(pp + off); xw[m][bj] = *(const u32x4*)(xb + off);
                }
#pragma unroll
            for (int m = 0; m < 4; ++m)
#pragma unroll
                for (int bj = 0; bj < 2; ++bj) {
                    const size_t off = (size_t)(u.pm * 256 + ai * 128 + wr * 64 + m * 16 + fr) * DM + u.pn * 256 + bj * 128 + wc * 32 + 8 * fq;
                    const u32x4 p = pw[m][bj], x = xw[m][bj];
                    const f32x4 a0 = acc[ai][bj][m][0] + b0[bj], a1 = acc[ai][bj][m][1] + b1[bj];
                    f32x4 x0, x1;
                    x0[0] = bflo(x.x) + sigmoidf_(a0[0]) * bflo(p.x); x0[1] = bfhi(x.x) + sigmoidf_(a0[1]) * bfhi(p.x); x0[2] = bflo(x.y) + sigmoidf_(a0[2]) * bflo(p.y); x0[3] = bfhi(x.y) + sigmoidf_(a0[3]) * bfhi(p.y);
                    x1[0] = bflo(x.z) + sigmoidf_(a1[0]) * bflo(p.z); x1[1] = bfhi(x.z) + sigmoidf_(a1[1]) * bfhi(p.z); x1[2] = bflo(x.w) + sigmoidf_(a1[2]) * bflo(p.w); x1[3] = bfhi(x.w) + sigmoidf_(a1[3]) * bfhi(p.w);
                    *(f32x4*)(out + off) = x0; *(f32x4*)(out + off + 4) = x1;
                }
        }
    }
};
}

DI int map_row(int mode, int n) {
    if (mode == 1) {
        if (n < 3840) return n;
        if (n < 4096) return 6400 + (n - 3840);
        if (n < 4352) return 3840 + (n - 4096);
        if (n < 4608) return 6656 + (n - 4352);
        if (n < 4656) return 6144 + (n - 4608);
        if (n < 5680) return 4096 + (n - 4656);
        return 5120 + (n - 5680);
    }
    if (mode == 2) {
        if (n < DFF) return 256 * (n >> 7) + (n & 127);
        const int uu = n - DFF; return 256 * (uu >> 7) + 128 + (uu & 127);
    }
    return n;
}
DI void transpose_item(const float* W, int K, int N, bf16* WT, int mode, LAS float* scr, int item, int lane) {
    const int nblk = (N + 31) / 32, kb = item / nblk, nb = item % nblk, k0 = 64 * kb, n0 = 32 * nb;
    const int r8 = lane >> 3, c4 = lane & 7;
    const bool okr = (n0 + 4 * c4) < N;
#pragma unroll
    for (int i = 0; i < 8; ++i) { const int kk = 8 * i + r8;
        const f32x4 v = okr ? *(const f32x4*)(W + (size_t)(k0 + kk) * N + n0 + 4 * c4) : (f32x4){0.f, 0.f, 0.f, 0.f};
        LAS float* d = scr + kk * 33 + 4 * c4; d[0] = v.x; d[1] = v.y; d[2] = v.z; d[3] = v.w; }
    LDS_WAIT(); asm volatile("" ::: "memory");
    const int c = lane & 7;
#pragma unroll
    for (int j = 0; j < 4; ++j) { const int n = (lane >> 3) + 8 * j; const LAS float* s = scr + (8 * c) * 33 + n;
        u32x4 o; o.x = pk2(s[0 * 33], s[1 * 33]); o.y = pk2(s[2 * 33], s[3 * 33]); o.z = pk2(s[4 * 33], s[5 * 33]); o.w = pk2(s[6 * 33], s[7 * 33]);
        if (n0 + n < N) *(u32x4*)(WT + (size_t)map_row(mode, n0 + n) * K + k0 + 8 * c) = o; }
    LDS_WAIT(); asm volatile("" ::: "memory");
}
template <int RR>
DI void rms_rows_to_bf16(const float* X, const float* g, bf16* Out, int m0, int stride, int lane) {
    f32x4 v[RR][4]; float s[RR];
#pragma unroll
    for (int r = 0; r < RR; ++r) { const f32x4* xr = (const f32x4*)(X + (size_t)(m0 + r * stride) * DM) + lane;
#pragma unroll
        for (int j = 0; j < 4; ++j) v[r][j] = xr[64 * j]; }
    f32x4 gg[4];
#pragma unroll
    for (int j = 0; j < 4; ++j) gg[j] = ((const f32x4*)g + lane)[64 * j];
#pragma unroll
    for (int r = 0; r < RR; ++r) { s[r] = 0.f;
#pragma unroll
        for (int j = 0; j < 4; ++j) s[r] += (v[r][j].x * v[r][j].x + v[r][j].y * v[r][j].y) + (v[r][j].z * v[r][j].z + v[r][j].w * v[r][j].w); }
#pragma unroll
    for (int r = 0; r < RR; ++r) {
        const float rs = rsqrtf(wave_sum(s[r]) * (1.f / DM) + NORM_EPS);
        u64* o8 = (u64*)(Out + (size_t)(m0 + r * stride) * DM) + lane;
#pragma unroll
        for (int j = 0; j < 4; ++j) o8[64 * j] = (u64)pk2(v[r][j].x * rs * gg[j].x, v[r][j].y * rs * gg[j].y) | ((u64)pk2(v[r][j].z * rs * gg[j].z, v[r][j].w * rs * gg[j].w) << 32);
    }
}

struct Args { const float* in[26]; float* out; unsigned char* ws; int ph_lo, ph_hi; };

DI void p0_prologue(const int wv, const Args& A, LAS unsigned char* lds, int G) {
    const int tid = TIDX, lane = tid & 63, wave = wv;
    unsigned char* ws = A.ws;
    if (blockIdx.x == 0 && tid < 8) ((unsigned*)(ws + WS_CTR))[tid * 16] = 0u;
    for (int it = blockIdx.x; it < 256; it += G) {
        const int mat = tid >> 8, j = tid & 255;
        const float* pos = A.in[12 + mat]; const float* w1 = A.in[mat ? 16 : 14];
        float s = 0.f;
#pragma unroll
        for (int k = 8 * it; k < 8 * it + 8; ++k) s += pos[k] * w1[(size_t)k * 256 + j];
        ((float*)(ws + WS_PART))[it * 512 + tid] = s;
    }
    LAS float* scr = (LAS float*)(lds + wave * 16384);
    const int gw = blockIdx.x * NWAVES + wave, NGW = G * NWAVES;
    constexpr int I_IN = 16 * 210, I_OUT = 16 * 32, I_GU = 16 * 176, I_DN = 44 * 32, I_PG = 16 * 32, I_PP = 4 * 32, I_C1 = 32 * 8, I_C2 = 4 * 2, I_L = 2;
    constexpr int NITEMS = I_IN + I_OUT + I_GU + I_DN + I_PG + I_PP + 2 * I_C1 + 2 * I_C2 + 32 * I_L;
    for (int it = gw; it < NITEMS; it += NGW) {
        int r = it;
        if (r < I_IN) { transpose_item(A.in[4], DM, DIN, (bf16*)(ws + WS_WIN), 1, scr, r, lane); continue; } r -= I_IN;
        if (r < I_OUT) { transpose_item(A.in[18], DM, DM, (bf16*)(ws + WS_WOUT), 0, scr, r, lane); continue; } r -= I_OUT;
        if (r < I_GU) { transpose_item(A.in[21], DM, 2 * DFF, (bf16*)(ws + WS_WGU), 2, scr, r, lane); continue; } r -= I_GU;
        if (r < I_DN) { transpose_item(A.in[22], DFF, DM, (bf16*)(ws + WS_WDN), 0, scr, r, lane); continue; } r -= I_DN;
        if (r < I_PG) { transpose_item(A.in[24], DM, DM, (bf16*)(ws + WS_WPG), 0, scr, r, lane); continue; } r -= I_PG;
        if (r < I_PP) { transpose_item(A.in[23], DPLE, DM, (bf16*)(ws + WS_WPP), 0, scr, r, lane); continue; } r -= I_PP;
        if (r < I_C1) { transpose_item(A.in[14], 2048, 256, (bf16*)(ws + WS_CW1K), 0, scr, r, lane); continue; } r -= I_C1;
        if (r < I_C1) { transpose_item(A.in[16], 2048, 256, (bf16*)(ws + WS_CW1V), 0, scr, r, lane); continue; } r -= I_C1;
        if (r < I_C2) { transpose_item(A.in[15], 256, 64, (bf16*)(ws + WS_CW2K), 0, scr, r, lane); continue; } r -= I_C2;
        if (r < I_C2) { transpose_item(A.in[17], 256, 64, (bf16*)(ws + WS_CW2V), 0, scr, r, lane); continue; } r -= I_C2;
        { const int mat = r / (16 * I_L), rr = r % (16 * I_L), nb = rr / I_L, sub = rr % I_L;
          transpose_item(A.in[mat ? 9 : 7] + (size_t)nb * 4096, 64, 64, (bf16*)(ws + (mat ? WS_LWX : WS_LWA)) + (size_t)nb * 4096, 0, scr, sub, lane); }
    }
    bf16* H = (bf16*)A.out;
    { int m = gw;
      for (; m + 7 * NGW < MTOK; m += 8 * NGW) rms_rows_to_bf16<8>(A.in[0], A.in[2], H, m, NGW, lane);
      for (; m + 3 * NGW < MTOK; m += 4 * NGW) rms_rows_to_bf16<4>(A.in[0], A.in[2], H, m, NGW, lane);
      for (; m < MTOK; m += NGW) rms_rows_to_bf16<1>(A.in[0], A.in[2], H, m, NGW, lane); }
}

constexpr int SC_W = 18432, SC_SLOT = 16640;
#define WAVE_SYNC() do { __builtin_amdgcn_fence(__ATOMIC_RELEASE, "wavefront"); __builtin_amdgcn_wave_barrier(); __builtin_amdgcn_fence(__ATOMIC_ACQUIRE, "wavefront"); } while (0)
template <int PASS>
DI void scan_item(const int wv, const Args& A, LAS unsigned char* lds, int item) {
    const int tid = TIDX, lane = tid & 63, wave = wv, fr = lane & 15, fq = lane >> 4;
    const int cg8 = item & 7, nblk = (item >> 3) & 15, b = item >> 7;
    const int j = cg8 * 8 + wave, ch = nblk * 64 + lane;
    unsigned char* ws = A.ws;
    const bf16* XR = (const bf16*)(ws + WS_XR); const bf16* GR = (const bf16*)(ws + WS_GR); const bf16* GMR = (const bf16*)((unsigned char*)A.out + 128 * MiB);
    bf16* Y = (bf16*)A.out;
    float2* AGG = (float2*)(ws + WS_AGG2);
    bf16* CT = (bf16*)(ws + WS_CT);
#pragma unroll
    for (int k = 0; k < 2; ++k) { const int id = tid + 512 * k, mat = id >> 9, row = (id >> 3) & 63, c8 = id & 7;
        const bf16* src = (const bf16*)(ws + (mat ? WS_LWX : WS_LWA)) + (size_t)nblk * 4096 + row * 64 + c8 * 8;
        *(LAS u32x4*)(lds + mat * 9216 + row * 144 + c8 * 16) = *(const u32x4*)src; }
    LAS unsigned char* wl = lds + SC_W + wave * SC_SLOT;
    LAS float* pre_r = (LAS float*)wl;
    LAS float* pre_i = (LAS float*)(wl + 4096);
    LAS bf16* xcb = (LAS bf16*)(wl + 8192);
    LAS bf16* SX = (LAS bf16*)(wl + 10496);
    LAS bf16* SG = (LAS bf16*)(wl + 12544);
    LAS bf16* SM = (LAS bf16*)(wl + 14592);
    const float cw0 = A.in[5][ch], cw1 = A.in[5][DM + ch], cw2 = A.in[5][2 * DM + ch], cw3 = A.in[5][3 * DM + ch], cb = A.in[6][ch];
    const float ba = A.in[8][ch], bx = A.in[10][ch];
    const float sp8 = -8.f * log1pf(__expf(-A.in[11][ch]));
    const int t0 = j * 128;
    const size_t rowb = (size_t)b * SEQ;
    float xm3 = 0.f, xm2 = 0.f, xm1 = 0.f;
    if (t0 > 0) { xm3 = bf2f(XR[(rowb + t0 - 3) * DM + ch]); xm2 = bf2f(XR[(rowb + t0 - 2) * DM + ch]); xm1 = bf2f(XR[(rowb + t0 - 1) * DM + ch]); }
    float h = 0.f, P = 1.f;
    const int ptok = lane >> 3, pc8 = lane & 7;
    const size_t gpiece = (size_t)ptok * DM + nblk * 64 + pc8 * 8;
    const int lpiece = ptok * 128 + pc8 * 16;
    u32x4 rx[2], rg[2], rm[2];
#pragma unroll
    for (int k = 0; k < 2; ++k) { const size_t o = (rowb + t0) * DM + gpiece + (size_t)k * 8 * DM;
        rx[k] = *(const u32x4*)(XR + o); rg[k] = *(const u32x4*)(GR + o); rm[k] = *(const u32x4*)(GMR + o); }
    __syncthreads();
    for (int step = 0; step < 8; ++step) {
        const int ts = t0 + step * 16;
#pragma unroll
        for (int k = 0; k < 2; ++k) { *(LAS u32x4*)((LAS unsigned char*)SX + lpiece + k * 1024) = rx[k]; *(LAS u32x4*)((LAS unsigned char*)SG + lpiece + k * 1024) = rg[k]; *(LAS u32x4*)((LAS unsigned char*)SM + lpiece + k * 1024) = rm[k]; }
        if (step < 7) {
#pragma unroll
            for (int k = 0; k < 2; ++k) { const size_t o = (rowb + ts + 16) * DM + gpiece + (size_t)k * 8 * DM;
                rx[k] = *(const u32x4*)(XR + o); rg[k] = *(const u32x4*)(GR + o); rm[k] = *(const u32x4*)(GMR + o); }
        }
        WAVE_SYNC();
        float xc[16];
#pragma unroll
        for (int tt = 0; tt < 16; ++tt) {
            const float x = bf2f(SX[tt * 64 + lane]);
            xc[tt] = cb + cw0 * xm3 + cw1 * xm2 + cw2 * xm1 + cw3 * x;
            xm3 = xm2; xm2 = xm1; xm1 = x;
            xcb[tt * 72 + lane] = (bf16)f2bf(xc[tt]);
        }
        WAVE_SYNC();
        {
            f32x4 ar[4], ai[4];
#pragma unroll
            for (int nt = 0; nt < 4; ++nt) { ar[nt] = (f32x4){0.f, 0.f, 0.f, 0.f}; ai[nt] = ar[nt]; }
#pragma unroll
            for (int ks = 0; ks < 2; ++ks) {
                const bf16x8 af = *(const LAS bf16x8*)(xcb + fr * 72 + ks * 32 + fq * 8);
#pragma unroll
                for (int nt = 0; nt < 4; ++nt) {
                    const bf16x8 wa = *(const LAS bf16x8*)(lds + (nt * 16 + fr) * 144 + ks * 64 + fq * 16);
                    const bf16x8 wx = *(const LAS bf16x8*)(lds + 9216 + (nt * 16 + fr) * 144 + ks * 64 + fq * 16);
                    ar[nt] = __builtin_amdgcn_mfma_f32_16x16x32_bf16(af, wa, ar[nt], 0, 0, 0); ai[nt] = __builtin_amdgcn_mfma_f32_16x16x32_bf16(af, wx, ai[nt], 0, 0, 0); }
            }
#pragma unroll
            for (int nt = 0; nt < 4; ++nt)
#pragma unroll
                for (int q = 0; q < 4; ++q) { pre_r[(fq * 4 + q) * 64 + nt * 16 + fr] = ar[nt][q]; pre_i[(fq * 4 + q) * 64 + nt * 16 + fr] = ai[nt][q]; }
        }
        WAVE_SYNC();
        {
            const f32x2_t ba2 = {ba, ba}, bx2 = {bx, bx}, sp2 = {sp8, sp8}, one2 = {1.f, 1.f};
            const f32x2_t nl2e = {-LOG2E, -LOG2E}, l2e = {LOG2E, LOG2E};
            LAS bf16* SY = SX; LAS bf16* SC = xcb;
#pragma unroll
            for (int tt = 0; tt < 16; tt += 2) {
                const f32x2_t pr = (f32x2_t){pre_r[tt * 64 + lane], pre_r[(tt + 1) * 64 + lane]} + ba2;
                const f32x2_t pi = (f32x2_t){pre_i[tt * 64 + lane], pre_i[(tt + 1) * 64 + lane]} + bx2;
                const f32x2_t cap = {60.f, 60.f};
                const f32x2_t tr = __builtin_elementwise_min(pr * nl2e, cap), ti = __builtin_elementwise_min(pi * nl2e, cap);
                const f32x2_t dr = (f32x2_t){__builtin_amdgcn_exp2f(tr.x), __builtin_amdgcn_exp2f(tr.y)} + one2;
                const f32x2_t di = (f32x2_t){__builtin_amdgcn_exp2f(ti.x), __builtin_amdgcn_exp2f(ti.y)} + one2;
                const f32x2_t dd = dr * di;
                const f32x2_t inv = {__builtin_amdgcn_rcpf(dd.x), __builtin_amdgcn_rcpf(dd.y)};
                const f32x2_t r = inv * di, ig = inv * dr;
                const f32x2_t la = r * sp2;
                const f32x2_t tl = la * l2e;
                const f32x2_t a = {__builtin_amdgcn_exp2f(tl.x), __builtin_amdgcn_exp2f(tl.y)};
                const f32x2_t x2 = la + la;
                f32x2_t om = x2 * (f32x2_t){1.f / 720.f, 1.f / 720.f} + (f32x2_t){1.f / 120.f, 1.f / 120.f};
                om = om * x2 + (f32x2_t){1.f / 24.f, 1.f / 24.f}; om = om * x2 + (f32x2_t){1.f / 6.f, 1.f / 6.f}; om = om * x2 + (f32x2_t){0.5f, 0.5f}; om = om * x2 + one2;
                om = om * (-x2);
                if (__builtin_amdgcn_ballot_w64((x2.x <= -0.25f) || (x2.y <= -0.25f)) != 0ull) {
                    asm volatile("" ::: "memory");
                    if (x2.x <= -0.25f) om.x = 1.f - a.x * a.x;
                    if (x2.y <= -0.25f) om.y = 1.f - a.y * a.y;
                }
                const f32x2_t omx = __builtin_elementwise_max(om, (f32x2_t){0.f, 0.f});
                const f32x2_t sq = {__builtin_amdgcn_sqrtf(omx.x), __builtin_amdgcn_sqrtf(omx.y)};
                const f32x2_t bb = sq * (ig * (f32x2_t){xc[tt], xc[tt + 1]});
                const float h0 = a.x * h + bb.x;
                const float h1 = a.y * h0 + bb.y;
                h = h1;
                const float P0 = P * a.x, P1 = P0 * a.y;
                P = P1;
                const f32x2_t gvv = {bf2f(SG[tt * 64 + lane]), bf2f(SG[(tt + 1) * 64 + lane])}, gmv = {bf2f(SM[tt * 64 + lane]), bf2f(SM[(tt + 1) * 64 + lane])};
                const f32x2_t g2 = gvv * gvv;
                const f32x2_t uu = gvv * (g2 * (f32x2_t){0.044715f, 0.044715f} + one2);
                const f32x2_t tg = __builtin_elementwise_min(uu * (f32x2_t){-2.f * 0.7978845608028654f * LOG2E, -2.f * 0.7978845608028654f * LOG2E}, cap), tm = __builtin_elementwise_min(gmv * nl2e, cap);
                const f32x2_t dg = (f32x2_t){__builtin_amdgcn_exp2f(tg.x), __builtin_amdgcn_exp2f(tg.y)} + one2;
                const f32x2_t dm = (f32x2_t){__builtin_amdgcn_exp2f(tm.x), __builtin_amdgcn_exp2f(tm.y)} + one2;
                const f32x2_t dq = dg * dm;
                const f32x2_t iq = {__builtin_amdgcn_rcpf(dq.x), __builtin_amdgcn_rcpf(dq.y)};
                const f32x2_t gq = gvv * iq;
                const f32x2_t yv = (f32x2_t){h0, h1} * gq, cv = (f32x2_t){P0, P1} * gq;
                SY[tt * 64 + lane] = (bf16)f2bf(yv.x); SY[(tt + 1) * 64 + lane] = (bf16)f2bf(yv.y);
                SC[tt * 64 + lane] = (bf16)f2bf(cv.x); SC[(tt + 1) * 64 + lane] = (bf16)f2bf(cv.y);
            }
        }
        WAVE_SYNC();
#pragma unroll
        for (int k = 0; k < 2; ++k) { const size_t o = (rowb + ts) * DM + gpiece + (size_t)k * 8 * DM;
            *(u32x4*)(Y + o) = *(const LAS u32x4*)((LAS unsigned char*)SX + lpiece + k * 1024);
            *(u32x4*)(CT + o) = *(const LAS u32x4*)((LAS unsigned char*)xcb + lpiece + k * 1024); }
        WAVE_SYNC();
    }
    AGG[((size_t)b * 64 + j) * DM + ch] = make_float2(P, h);
}

struct ACtx { int h, n, qi, r, t, wave; float slope2; unsigned slopew, slope16w; bf16x8 qf[4], akey[2]; u64 sel_lo, sel_hi, wun_lo, wun_hi; };
DI int m128_first(u64 lo, u64 hi) { return lo ? (__ffsll((long long)lo) - 1) : (hi ? 64 + (__ffsll((long long)hi) - 1) : -1); }
DI int m128_last(u64 lo, u64 hi) { return hi ? (127 - __clzll((long long)hi)) : (lo ? (63 - __clzll((long long)lo)) : -1); }
DI bool m128_bit(u64 lo, u64 hi, int j) { return j < 64 ? ((lo >> j) & 1ull) : ((hi >> (j - 64)) & 1ull); }
DI void m128_clear(u64& lo, u64& hi, int j) { if (j < 64) lo &= ~(1ull << j); else hi &= ~(1ull << (j - 64)); }
#define MFMA32(a, b, c) __builtin_amdgcn_mfma_f32_32x32x16_bf16((a), (b), (c), 0, 0, 0)

template <int BR, int NT, int DV>
DI void attn_compute(LAS unsigned char* kbA, LAS unsigned char* vbA, LAS unsigned char* kbB, LAS unsigned char* vbB, const int jA, const int jB,
                     const ACtx& c, const int qb, float& m, float& l, f32x16 (&O)[2], float m_fin, float inv_l, LAS float* imp_row, float& carry) {
    f32x16 s[2 * NT];
#pragma unroll
    for (int ti = 0; ti < NT; ++ti) {
        LAS unsigned char* kb = ti ? kbB : kbA; const int j = ti ? jB : jA;
#pragma unroll
        for (int i = 0; i < 16; ++i) { s[2 * ti][i] = 0.f; s[2 * ti + 1][i] = 0.f; }
#pragma unroll
        for (int ks = 0; ks < ((DV & 4) ? 0 : 4); ++ks) {
            const bf16x8 a0 = *(const LAS bf16x8*)(kb + c.n * 144 + ks * 32 + c.h * 16);
            const bf16x8 a1 = *(const LAS bf16x8*)(kb + (32 + c.n) * 144 + ks * 32 + c.h * 16);
            s[2 * ti] = MFMA32(a0, c.qf[ks], s[2 * ti]); s[2 * ti + 1] = MFMA32(a1, c.qf[ks], s[2 * ti + 1]);
        }
        {
            const int pos0 = (BR <= 1) ? (1024 * j + 31 - c.t) : (64 * j - c.t);
            float tb = c.slope2 * (float)pos0;
            if (BR == 2) { if (!m128_bit(c.sel_lo, c.sel_hi, j)) tb = -1e30f; }
            const unsigned thi = f2bf(tb); const unsigned tlo = f2bf(tb - bf2f(thi));
            u32x4 bw = (u32x4){(BR <= 1) ? c.slope16w : c.slopew, thi | (tlo << 16), 0u, 0u};
            if (c.h) bw = (u32x4){0u, 0u, 0u, 0u};
            const bf16x8 bb = __builtin_bit_cast(bf16x8, bw);
            s[2 * ti] = MFMA32(c.akey[0], bb, s[2 * ti]); s[2 * ti + 1] = MFMA32(c.akey[1], bb, s[2 * ti + 1]);
        }
        bool bnd;
        if (BR <= 1) bnd = (64 * j + 63 > 4 * qb - 2); else if (BR == 2) bnd = (j == qb); else bnd = (j == qb) || (j + 8 == qb);
        if (bnd) {
            asm volatile("" ::: "memory");
            const int d0 = (BR <= 1) ? (c.t - 31 - 1024 * j) : (c.t - 64 * j);
#pragma unroll
            for (int kt = 0; kt < 2; ++kt)
#pragma unroll
                for (int rr = 0; rr < 16; ++rr) {
                    const int key = kt * 32 + (rr & 3) + 8 * (rr >> 2) + 4 * c.h;
                    const int dist = (BR <= 1) ? (d0 - 16 * key) : (d0 - key);
                    bool valid = dist >= 0;
                    if (BR == 3) valid = valid && (dist < 512);
                    s[2 * ti + kt][rr] = valid ? s[2 * ti + kt][rr] : -INFINITY;
                }
        }
    }
    float m_use, alpha = 1.f; bool grow = false;
    float mx = -INFINITY;
#pragma unroll
    for (int q = 0; q < 2 * NT; ++q)
#pragma unroll
        for (int i = 0; i < 16; ++i) mx = fmaxf(mx, s[q][i]);
    if (BR == 1) { m_use = m_fin; }
    else {
        mx = fmaxf(mx, __shfl_xor(mx, 32));
        if (mx < -1e29f) mx = -INFINITY;
        const float m_new = fmaxf(m, mx);
        grow = m_new > m;
        m_use = (m_new == -INFINITY) ? 0.f : m_new;
        alpha = __builtin_amdgcn_exp2f(m - m_use);
        m = m_new;
    }
    if (__builtin_amdgcn_ballot_w64((mx - m_use) > -150.f) == 0ull) {
        if (BR == 1) {
#pragma unroll
            for (int ti = 0; ti < NT; ++ti)
#pragma unroll
                for (int kt = 0; kt < 2; ++kt)
#pragma unroll
                    for (int v = 0; v < 4; ++v) { const int j = ti ? jB : jA; const float add = c.h ? 0.f : carry; carry = 0.f; if (c.r == 0) imp_row[16 * j + 8 * kt + 2 * v + c.h] = add; }
        }
        return;
    }
    f32x2_t sum2 = {0.f, 0.f}; const f32x2_t mm2 = {m_use, m_use}, il2 = {inv_l, inv_l};
#pragma unroll
    for (int q = 0; q < 2 * NT; ++q)
#pragma unroll
        for (int rr = 0; rr < 16; rr += 2) {
            const f32x2_t d = (f32x2_t){s[q][rr], s[q][rr + 1]} - mm2;
            f32x2_t p = (DV & 1) ? d : (f32x2_t){__builtin_amdgcn_exp2f(d.x), __builtin_amdgcn_exp2f(d.y)};
            if (BR == 1) p *= il2;
            s[q][rr] = p.x; s[q][rr + 1] = p.y; sum2 += p;
        }
    float sum = sum2.x + sum2.y;
    if (BR != 1) { sum += __shfl_xor(sum, 32); l = l * alpha + sum; }
    if (BR == 1) {
#pragma unroll
        for (int ti = 0; ti < NT; ++ti)
#pragma unroll
            for (int kt = 0; kt < 2; ++kt)
#pragma unroll
                for (int v = 0; v < 4; ++v) {
                    const int j = ti ? jB : jA;
                    float a = 2.f * (s[2 * ti + kt][4 * v] + s[2 * ti + kt][4 * v + 1] + s[2 * ti + kt][4 * v + 2]) + s[2 * ti + kt][4 * v + 3], bc = s[2 * ti + kt][4 * v + 3];
                    a += dpp_f<0xB1>(a); a += dpp_f<0x4E>(a); bc += dpp_f<0xB1>(bc); bc += dpp_f<0x4E>(bc);
                    const float bo = __shfl_xor(bc, 32);
                    const float add = a + (c.h ? bo : carry);
                    carry = bo;
                    if (c.r == 0) imp_row[16 * j + 8 * kt + 2 * v + c.h] = add;
                }
    }
    if (BR != 0) {
        if (BR != 1) {
            if (__builtin_amdgcn_ballot_w64(grow) != 0ull) {
#pragma unroll
                for (int i = 0; i < 16; ++i) { O[0][i] *= alpha; O[1][i] *= alpha; }
            }
        }
        if (!(DV & 2) && __builtin_amdgcn_ballot_w64(sum > 0.f) != 0ull) {
#pragma unroll
            for (int ti = 0; ti < NT; ++ti)
#pragma unroll
                for (int kt = 0; kt < 2; ++kt)
#pragma unroll
                    for (int u = 0; u < 2; ++u) {
                        LAS unsigned char* vb = ti ? vbB : vbA;
                        const f32x16& sv = s[2 * ti + kt];
                        u32x4 pw; pw.x = pk2(sv[8 * u], sv[8 * u + 1]); pw.y = pk2(sv[8 * u + 2], sv[8 * u + 3]); pw.z = pk2(sv[8 * u + 4], sv[8 * u + 5]); pw.w = pk2(sv[8 * u + 6], sv[8 * u + 7]);
                        const bf16x8 pf = __builtin_bit_cast(bf16x8, pw);
                        const int kbase = kt * 32 + 16 * u;
#pragma unroll
                        for (int mt = 0; mt < 2; ++mt) {
                            const LAS unsigned char* vp = vb + (mt * 32 + c.n) * 136 + (kbase + 4 * c.h) * 2;
                            const u32x2 lo = *(const LAS u32x2*)vp, hi = *(const LAS u32x2*)(vp + 16);
                            const bf16x8 af = __builtin_bit_cast(bf16x8, (u32x4){lo.x, lo.y, hi.x, hi.y});
                            O[mt] = MFMA32(af, pf, O[mt]);
                        }
                    }
        }
    }
}

constexpr int AT_PAIR = 35840, AT_K1 = 9216, AT_V0 = 18432, AT_V1 = 18432 + 8704;
template <int BR, int DV>
DI void attn_tiles(const int wv, LAS unsigned char* lds, const bf16* Kbase, size_t ldk, size_t ktile, const bf16* Vbase, size_t ldv, size_t vtile,
                   u64 mlo, u64 mhi, const ACtx& c, const int qb, float& m, float& l, f32x16 (&O)[2], float m_fin, float inv_l, LAS float* imp_row, float& carry) {
    constexpr bool DESC = (BR >= 2) || (BR == 0);
    const int tid = TIDX, srow = tid >> 3, sch = tid & 7;
#define AT_NEXT() (DESC ? m128_last(mlo, mhi) : m128_first(mlo, mhi))
#define AT_LOAD(RK, RV, JJ) do { RK = *(const u32x4*)(Kbase + (size_t)(JJ) * ktile + (size_t)srow * ldk + sch * 8); \
        if (BR != 0) RV = *(const u32x4*)(Vbase + (size_t)(JJ) * vtile + (size_t)srow * ldv + sch * 8); } while (0)
#define AT_WRITE(RK, RV, KOFF, VOFF) do { *(LAS u32x4*)(pb + (KOFF) + srow * 144 + sch * 16) = RK; \
        if (BR != 0) { *(LAS u32x2*)(pb + (VOFF) + srow * 136 + sch * 16) = (u32x2){RV.x, RV.y}; *(LAS u32x2*)(pb + (VOFF) + srow * 136 + sch * 16 + 8) = (u32x2){RV.z, RV.w}; } } while (0)
    int j0 = AT_NEXT();
    if (j0 < 0) return;
    m128_clear(mlo, mhi, j0);
    int j1 = AT_NEXT();
    if (j1 >= 0) m128_clear(mlo, mhi, j1);
    u32x4 rk0, rv0 = (u32x4){0u, 0u, 0u, 0u}, rk1 = (u32x4){0u, 0u, 0u, 0u}, rv1 = (u32x4){0u, 0u, 0u, 0u};
    AT_LOAD(rk0, rv0, j0);
    if (j1 >= 0) AT_LOAD(rk1, rv1, j1);
    int buf = 0;
    __syncthreads();
    while (j0 >= 0) {
        LAS unsigned char* pb = lds + buf * AT_PAIR;
        AT_WRITE(rk0, rv0, 0, AT_V0);
        if (j1 >= 0) AT_WRITE(rk1, rv1, AT_K1, AT_V1);
        int n0 = (j1 >= 0) ? AT_NEXT() : -1;
        if (n0 >= 0) m128_clear(mlo, mhi, n0);
        int n1 = (n0 >= 0) ? AT_NEXT() : -1;
        if (n1 >= 0) m128_clear(mlo, mhi, n1);
        if (n0 >= 0) AT_LOAD(rk0, rv0, n0);
        if (n1 >= 0) AT_LOAD(rk1, rv1, n1);
        __syncthreads();
        const bool act0 = (BR != 2) || m128_bit(c.wun_lo, c.wun_hi, j0);
        const bool act1 = (j1 >= 0) && ((BR != 2) || m128_bit(c.wun_lo, c.wun_hi, j1));
        if (act0 && act1) attn_compute<BR, 2, DV>(pb, pb + AT_V0, pb + AT_K1, pb + AT_V1, j0, j1, c, qb, m, l, O, m_fin, inv_l, imp_row, carry);
        else if (act0) attn_compute<BR, 1, DV>(pb, pb + AT_V0, pb, pb + AT_V0, j0, j0, c, qb, m, l, O, m_fin, inv_l, imp_row, carry);
        else if (act1) attn_compute<BR, 1, DV>(pb + AT_K1, pb + AT_V1, pb + AT_K1, pb + AT_V1, j1, j1, c, qb, m, l, O, m_fin, inv_l, imp_row, carry);
        j0 = n0; j1 = n1; buf ^= 1;
    }
#undef AT_NEXT
#undef AT_LOAD
#undef AT_WRITE
}

template <int DV>
DI void attn_unit(const int wv, const Args& A, LAS unsigned char* lds, int b, int g, int qb, int dry) {
    const int tid = TIDX, lane = tid & 63, wave = wv;
    unsigned char* ws = A.ws;
    ACtx c; c.h = lane >> 5; c.n = lane & 31; c.qi = c.n >> 2; c.r = c.n & 3; c.wave = wave; c.t = qb * 64 + wave * 8 + c.qi;
    const int head = g * 4 + c.r;
    c.slope2 = __builtin_amdgcn_exp2f(-0.5f * (float)(head + 1)) * LOG2E;
    { const unsigned shi = f2bf(c.slope2); const float slo = c.slope2 - bf2f(shi); c.slopew = shi | (f2bf(slo) << 16); c.slope16w = f2bf(16.f * bf2f(shi)) | (f2bf(16.f * slo) << 16);
#pragma unroll
      for (int kt = 0; kt < 2; ++kt) { const unsigned kk = f2bf((float)(kt * 32 + c.n)); u32x4 aw = (u32x4){kk | (kk << 16), 0x3F803F80u, 0u, 0u}; if (c.h) aw = (u32x4){0u, 0u, 0u, 0u}; c.akey[kt] = __builtin_bit_cast(bf16x8, aw); } }
    c.sel_lo = c.sel_hi = c.wun_lo = c.wun_hi = 0ull;
    const size_t tokrow = (size_t)b * SEQ + c.t;
    { const bf16* q = (const bf16*)(ws + WS_Q) + tokrow * DM + head * 64 + 8 * c.h;
#pragma unroll
      for (int ks = 0; ks < 4; ++ks) c.qf[ks] = *(const bf16x8*)(q + ks * 16); }
    LAS float* IMP = (LAS float*)(lds + 71680);
    LAS u64* SEL = (LAS u64*)(lds + 137216);
    LAS u64* WUN = (LAS u64*)(lds + 138240);
    LAS float* imp_row = IMP + (wave * 8 + c.qi) * 132;
    const bf16* gn = (const bf16*)(ws + WS_GNSA) + tokrow * 64 + head * 3;
    const float g0 = sigmoidf_(bf2f(gn[0])), g1 = sigmoidf_(bf2f(gn[1])), g2 = sigmoidf_(bf2f(gn[2]));
    f32x16 O[2];
#pragma unroll
    for (int i = 0; i < 16; ++i) { O[0][i] = 0.f; O[1][i] = 0.f; }
    LAS float* ypark = (LAS float*)(lds + 71680 + wave * 8192) + lane;
    float m, l, carry = 0.f;
    if (!(dry & 2)) {
    const int nT = (4 * qb + 2) / 64 + 1;
    const u64 cm = (nT >= 64) ? ~0ull : ((1ull << nT) - 1ull);
    const bf16* Kc = (const bf16*)(ws + WS_KCC) + (size_t)(g * 8 + b) * 512 * 64;
    const bf16* Vc = (const bf16*)(ws + WS_VCT) + (size_t)(g * 8 + b) * 512;
    m = -INFINITY; l = 0.f;
    attn_tiles<0, DV>(wv, lds, Kc, 64, 64 * 64, Vc, 16384, 64, cm, 0ull, c, qb, m, l, O, 0.f, 0.f, imp_row, carry);
    {
        const float m_fin = (m == -INFINITY) ? 0.f : m, inv_l = 1.f / fmaxf(l, 1e-30f);
#pragma unroll
        for (int i = 0; i < 16; ++i) { O[0][i] = 0.f; O[1][i] = 0.f; }
        carry = 0.f;
        attn_tiles<1, DV>(wv, lds, Kc, 64, 64 * 64, Vc, 16384, 64, cm, 0ull, c, qb, m, l, O, m_fin, inv_l, imp_row, carry);
    }
    }
    __syncthreads();
    if (!(dry & 4)) {
        const int qi2 = lane >> 3, l8 = lane & 7;
        const LAS float* irow = IMP + (wave * 8 + qi2) * 132;
        u64 slo = 0ull, shi = 0ull;
        if (qb + 1 <= 16) { slo = (1ull << (qb + 1)) - 1ull; }
        else {
            float sc[16]; unsigned selm = 0u;
#pragma unroll
            for (int i = 0; i < 16; ++i) { const int jj = l8 + 8 * i; const bool forced = (jj == 0 || jj == qb || jj == qb - 1);
                const bool cand = (jj <= qb) && !forced; sc[i] = cand ? irow[jj] : -1.f; if (forced) selm |= 1u << i; }
            for (int round = 0; round < 13; ++round) {
                float lm = sc[0];
#pragma unroll
                for (int i = 1; i < 16; ++i) lm = fmaxf(lm, sc[i]);
                lm = fmaxf(lm, dpp_f<0xB1>(lm)); lm = fmaxf(lm, dpp_f<0x4E>(lm)); lm = fmaxf(lm, dpp_f<0x141>(lm));
                int li = 99;
#pragma unroll
                for (int i = 15; i >= 0; --i) li = (sc[i] == lm) ? i : li;
                int cj = (li < 16) ? (l8 + 8 * li) : 999;
                cj = min(cj, dpp_i<0xB1>(cj)); cj = min(cj, dpp_i<0x4E>(cj)); cj = min(cj, dpp_i<0x141>(cj));
                const int tt = cj - l8;
#pragma unroll
                for (int i = 0; i < 16; ++i) { const bool hit = (tt == 8 * i); sc[i] = hit ? -1.f : sc[i]; selm |= hit ? (1u << i) : 0u; }
            }
#pragma unroll
            for (int i = 0; i < 16; ++i) { if ((selm >> i) & 1u) { if (i < 8) slo |= 1ull << (l8 + 8 * i); else shi |= 1ull << (l8 + 8 * (i - 8)); } }
        }
        unsigned w0 = (unsigned)slo, w1 = (unsigned)(slo >> 32), w2 = (unsigned)shi, w3 = (unsigned)(shi >> 32);
#pragma unroll
        for (int o = 1; o < 8; o <<= 1) { w0 |= __shfl_xor(w0, o); w1 |= __shfl_xor(w1, o); w2 |= __shfl_xor(w2, o); w3 |= __shfl_xor(w3, o); }
        if (l8 == 0) { SEL[(wave * 8 + qi2) * 2] = ((u64)w1 << 32) | w0; SEL[(wave * 8 + qi2) * 2 + 1] = ((u64)w3 << 32) | w2; }
#pragma unroll
        for (int o = 8; o < 64; o <<= 1) { w0 |= __shfl_xor(w0, o); w1 |= __shfl_xor(w1, o); w2 |= __shfl_xor(w2, o); w3 |= __shfl_xor(w3, o); }
        if (lane == 0) { WUN[wave * 2] = ((u64)w1 << 32) | w0; WUN[wave * 2 + 1] = ((u64)w3 << 32) | w2; }
        c.wun_lo = ((u64)w1 << 32) | w0; c.wun_hi = ((u64)w3 << 32) | w2;
    }
    __syncthreads();
    u64 bun_lo = 0ull, bun_hi = 0ull;
#pragma unroll
    for (int w = 0; w < 8; ++w) { bun_lo |= WUN[w * 2]; bun_hi |= WUN[w * 2 + 1]; }
    c.sel_lo = SEL[(wave * 8 + c.qi) * 2]; c.sel_hi = SEL[(wave * 8 + c.qi) * 2 + 1];
#pragma unroll
    for (int i = 0; i < 16; ++i) { ypark[i * 64] = g0 * O[0][i]; ypark[(16 + i) * 64] = g0 * O[1][i]; }
    if (!(dry & 8)) {
        const bf16* Ks = (const bf16*)(ws + WS_KSL) + (size_t)b * SEQ * 256 + g * 64;
        const bf16* Vs = (const bf16*)(ws + WS_VTSL) + (size_t)(g * 64) * MTOK + (size_t)b * SEQ;
        m = -INFINITY; l = 0.f;
#pragma unroll
        for (int i = 0; i < 16; ++i) { O[0][i] = 0.f; O[1][i] = 0.f; }
        attn_tiles<2, DV>(wv, lds, Ks, 256, 64 * 256, Vs, MTOK, 64, bun_lo, bun_hi, c, qb, m, l, O, 0.f, 0.f, imp_row, carry);
        const float sc = g1 / fmaxf(l, 1e-30f);
#pragma unroll
        for (int i = 0; i < 16; ++i) { ypark[i * 64] += sc * O[0][i]; ypark[(16 + i) * 64] += sc * O[1][i]; }
    }
    if (!(dry & 16)) {
        const bf16* Kw = (const bf16*)(ws + WS_KW) + (size_t)b * SEQ * 256 + g * 64;
        const bf16* Vw = (const bf16*)(ws + WS_VTW) + (size_t)(g * 64) * MTOK + (size_t)b * SEQ;
        const int jlo = qb >= 8 ? qb - 8 : 0;
        u64 wlo = 0ull, whi = 0ull;
        for (int jj = jlo; jj <= qb; ++jj) { if (jj < 64) wlo |= 1ull << jj; else whi |= 1ull << (jj - 64); }
        m = -INFINITY; l = 0.f;
#pragma unroll
        for (int i = 0; i < 16; ++i) { O[0][i] = 0.f; O[1][i] = 0.f; }
        attn_tiles<3, DV>(wv, lds, Kw, 256, 64 * 256, Vw, MTOK, 64, wlo, whi, c, qb, m, l, O, 0.f, 0.f, imp_row, carry);
        const float sc = g2 / fmaxf(l, 1e-30f);
#pragma unroll
        for (int i = 0; i < 16; ++i) { O[0][i] = ypark[i * 64] + sc * O[0][i]; O[1][i] = ypark[(16 + i) * 64] + sc * O[1][i]; }
    }
    if (!(dry & 32))
    {
        bf16* Yb = (bf16*)A.out; const bf16* GMA = (const bf16*)(ws + WS_GMA);
#pragma unroll
        for (int mt = 0; mt < 2; ++mt)
#pragma unroll
            for (int v = 0; v < 4; ++v) {
                const size_t idx = tokrow * DM + head * 64 + mt * 32 + 8 * v + 4 * c.h;
                const u32x2 yr = *(const u32x2*)(Yb + idx), gm = *(const u32x2*)(GMA + idx), ct = *(const u32x2*)((const bf16*)(ws + WS_CT) + idx);
                const f32x4 cr = *(const f32x4*)((const float*)(ws + WS_CARRY) + ((size_t)b * 64 + (c.t >> 7)) * DM + head * 64 + mt * 32 + 8 * v + 4 * c.h);
                const float o0 = bflo(yr.x) + bflo(ct.x) * cr[0] + sigmoidf_(bflo(gm.x)) * O[mt][4 * v], o1 = bfhi(yr.x) + bfhi(ct.x) * cr[1] + sigmoidf_(bfhi(gm.x)) * O[mt][4 * v + 1];
                const float o2 = bflo(yr.y) + bflo(ct.y) * cr[2] + sigmoidf_(bflo(gm.y)) * O[mt][4 * v + 2], o3 = bfhi(yr.y) + bfhi(ct.y) * cr[3] + sigmoidf_(bfhi(gm.y)) * O[mt][4 * v + 3];
                *(u32x2*)(((dry & 1) ? (bf16*)(ws + 832 * MiB) : Yb) + idx) = (u32x2){pk2(o0, o1), pk2(o2, o3)};
            }
    }
}

template <bool NORM2>
DI void row_phase(const int wv, const bf16* RAW, const float* base, bf16* XB, bf16* NB, const float* g1, const float* g2, int G) {
    const int tid = TIDX, lane = tid & 63, wave = wv;
    const int gw = blockIdx.x * NWAVES + wave, NGW = G * NWAVES;
    constexpr int R = 4;
    for (int row0 = gw; row0 < MTOK; row0 += R * NGW) {
        float v[R][16], x[R][16];
#pragma unroll
        for (int r = 0; r < R; ++r) {
            const int row = (row0 + r * NGW < MTOK) ? row0 + r * NGW : row0;
#pragma unroll
            for (int jj = 0; jj < 2; ++jj) {
                const size_t off = (size_t)row * DM + 8 * lane + 512 * jj;
                const u32x4 rw = *(const u32x4*)(RAW + off);
                v[r][8 * jj + 0] = bflo(rw.x); v[r][8 * jj + 1] = bfhi(rw.x); v[r][8 * jj + 2] = bflo(rw.y); v[r][8 * jj + 3] = bfhi(rw.y);
                v[r][8 * jj + 4] = bflo(rw.z); v[r][8 * jj + 5] = bfhi(rw.z); v[r][8 * jj + 6] = bflo(rw.w); v[r][8 * jj + 7] = bfhi(rw.w);
                if (NORM2) {
                    const f32x4 x0 = *(const f32x4*)(base + off), x1 = *(const f32x4*)(base + off + 4);
                    x[r][8 * jj + 0] = x0[0]; x[r][8 * jj + 1] = x0[1]; x[r][8 * jj + 2] = x0[2]; x[r][8 * jj + 3] = x0[3]; x[r][8 * jj + 4] = x1[0]; x[r][8 * jj + 5] = x1[1]; x[r][8 * jj + 6] = x1[2]; x[r][8 * jj + 7] = x1[3];
                } else {
                    const u32x4 xw = *(const u32x4*)(XB + off);
                    x[r][8 * jj + 0] = bflo(xw.x); x[r][8 * jj + 1] = bfhi(xw.x); x[r][8 * jj + 2] = bflo(xw.y); x[r][8 * jj + 3] = bfhi(xw.y);
                    x[r][8 * jj + 4] = bflo(xw.z); x[r][8 * jj + 5] = bfhi(xw.z); x[r][8 * jj + 6] = bflo(xw.w); x[r][8 * jj + 7] = bfhi(xw.w);
                }
            }
        }
        float ga[16], gb[16];
#pragma unroll
        for (int jj = 0; jj < 2; ++jj)
#pragma unroll
            for (int i = 0; i < 8; ++i) { ga[8 * jj + i] = g1[8 * lane + 512 * jj + i]; gb[8 * jj + i] = NORM2 ? g2[8 * lane + 512 * jj + i] : 1.f; }
#pragma unroll
        for (int r = 0; r < R; ++r) {
            const int row = row0 + r * NGW;
            float ss = 0.f;
#pragma unroll
            for (int i = 0; i < 16; ++i) ss += v[r][i] * v[r][i];
            const float rs = rsqrtf(wave_sum(ss) * (1.f / DM) + NORM_EPS);
            float ss2 = 0.f;
#pragma unroll
            for (int i = 0; i < 16; ++i) { const float o = x[r][i] + v[r][i] * rs * ga[i]; x[r][i] = o; ss2 += o * o; }
            float rs2 = 1.f;
            if (NORM2) rs2 = rsqrtf(wave_sum(ss2) * (1.f / DM) + NORM_EPS);
            if (row < MTOK) {
#pragma unroll
                for (int jj = 0; jj < 2; ++jj) {
                    const size_t off = (size_t)row * DM + 8 * lane + 512 * jj;
                    const float* xx = &x[r][8 * jj];
                    const u32x4 xw = (u32x4){pk2(xx[0], xx[1]), pk2(xx[2], xx[3]), pk2(xx[4], xx[5]), pk2(xx[6], xx[7])};
                    if (NORM2) {
                        *(u32x4*)(XB + off) = xw;
                        float y[8];
#pragma unroll
                        for (int i = 0; i < 8; ++i) y[i] = xx[i] * rs2 * gb[8 * jj + i];
                        *(u32x4*)(NB + off) = (u32x4){pk2(y[0], y[1]), pk2(y[2], y[3]), pk2(y[4], y[5]), pk2(y[6], y[7])};
                    } else {
                        *(u32x4*)(NB + off) = xw;
                    }
                }
            }
        }
    }
}

__global__ void __launch_bounds__(NTHR, 2) hybrid_fwd(Args args) {
    extern __shared__ __attribute__((aligned(16))) unsigned char lds_raw[];
    LAS unsigned char* lds = (LAS unsigned char*)lds_raw;
    const int G = gridDim.x, bx = blockIdx.x;
    const int wv = __builtin_amdgcn_readfirstlane(threadIdx.x >> 6);
    unsigned char* ws = args.ws; unsigned char* dout = (unsigned char*)args.out;
    const int lo = args.ph_lo, hi = args.ph_hi;
#ifndef PHMASK
#define PHMASK 0xFFFF
#endif
#define IN(k) (((PHMASK >> (k)) & 1) && lo <= (k) && (k) < hi)
    volatile LAS unsigned* xst = (volatile LAS unsigned*)(lds + LDS_SLOT + 64);
    unsigned* xbar = (unsigned*)(ws + WS_BAR); unsigned xcc = 0u;
    if (hi - lo > 1) {
        if (wv == 0) { if (lane_id() == 0) { xst[0] = 0u; xst[1] = 0u;
            const __attribute__((address_space(4))) char* ia = (const __attribute__((address_space(4))) char*)__builtin_amdgcn_implicitarg_ptr();
            const unsigned long long p = *(const __attribute__((address_space(4))) unsigned long long*)(ia + 88);
            if (*(const unsigned*)(p + 40) != (unsigned)G) (void)xb_add(&xbar[XB_TMO], 0u); } }
        xcc = xb_xcc_id();
        if (wv == 0) { if (lane_id() == 0) (void)xb_add(&xbar[XB_XCNT(xcc)], 1u); }
        __syncthreads();
    }
#define SEAM(k) do { if (IN(k) && IN((k) + 1)) { xcd_barrier(wv, xbar, xcc, xst); } } while (0)
    using namespace pg8;

    for (int rep = 0; rep < (((PROBE_MASK >> 0) & 1) ? 2 : 1); ++rep) if (IN(0)) { p0_prologue(wv, args, lds, G); }
    SEAM(0);
    for (int rep = 0; rep < (((PROBE_MASK >> 1) & 1) ? 2 : 1); ++rep) if (IN(1)) {
        { GemmD g{(const char*)dout, (const char*)(ws + WS_WIN), DM, DM, DM, 128, 128, 0}; Sched S; S.init(256, 25, G, bx); EpiSec E{ws, dout};
          gemm_phase<EpiSec, true>(wv, lds, g, S, E); }
        { GemmD g{(const char*)(ws + WS_WV), (const char*)dout, DM, DM, DM, 128, 128, 0}; Sched S; S.init(2, 256, G, bx);
          EpiStore<0, 0> E{(bf16*)(ws + WS_VTSL), (size_t)MTOK, nullptr, 512, MTOK};
          gemm_phase<EpiStore<0, 0>, true>(wv, lds, g, S, E); }
    }
    SEAM(1);
    for (int rep = 0; rep < (((PROBE_MASK >> 2) & 1) ? 2 : 1); ++rep) if (IN(2)) {
        float* posbp = (float*)(ws + WS_POSBP) + (size_t)(bx & 255) * 512;
        { const int tid = TIDX; const int cv = (bx + G / 2) % G; const int mat = tid >> 8;
          if (mat == 0 ? (bx < 64) : (cv < 64)) { float t = 0.f; const float* part = (const float*)(ws + WS_PART) + tid;
              for (int it = 0; it < 256; ++it) t += part[it * 512];
              posbp[tid] = t; }
          asm volatile("s_waitcnt vmcnt(0)" ::: "memory"); __syncthreads(); }
        { GemmD g{(const char*)(ws + WS_KC), (const char*)(ws + WS_CW1K), 2048, 16 * 256, 2048, 512, 128, 1}; Sched S; S.init(64, 1, G, bx);
          EpiStore<1, 0> E{(bf16*)(ws + WS_HIDK), 256, posbp, 16384, 256};
          gemm_phase<EpiStore<1, 0>, false>(wv, lds, g, S, E); }
        { GemmD g{(const char*)(ws + WS_VC), (const char*)(ws + WS_CW1V), 2048, 16 * 256, 2048, 512, 128, 1}; Sched S; S.init(64, 1, G, (bx + G / 2) % G);
          EpiStore<1, 0> E{(bf16*)(ws + WS_HIDV), 256, posbp + 256, 16384, 256};
          gemm_phase<EpiStore<1, 0>, false>(wv, lds, g, S, E); }
        { GemmD g{(const char*)(ws + WS_HIDK), (const char*)(ws + WS_CW2K), 256, 256, 256, 128, 128, 0}; Sched S; S.init(64, 1, G, bx);
          EpiStore<0, 1> E{(bf16*)(ws + WS_KCC), 64, nullptr, 16384, 64};
          gemm_phase<EpiStore<0, 1>, false>(wv, lds, g, S, E); }
        { GemmD g{(const char*)(ws + WS_CW2V), (const char*)(ws + WS_HIDV), 256, 256, 256, 128, 128, 0}; Sched S; S.init(1, 64, G, (bx + G / 2) % G);
          EpiStore<0, 2> E{(bf16*)(ws + WS_VCT), 16384, nullptr, 64, 16384};
          gemm_phase<EpiStore<0, 2>, false>(wv, lds, g, S, E); }
        __syncthreads();
        for (;;) { const int it = next_item(wv, lds, (unsigned*)(ws + WS_CTR) + 64 * rep); if (it >= 1024) break; scan_item<2>(wv, args, lds, it); }
    }
    SEAM(2);
    for (int rep = 0; rep < (((PROBE_MASK >> 3) & 1) ? 2 : 1); ++rep) if (IN(3)) {
        __syncthreads();
        {
            const int gt = bx * NTHR + TIDX;
            if (gt < NB * DM) { const int b = gt >> 10, ch = gt & 1023; const float2* AG = (const float2*)(ws + WS_AGG2) + (size_t)b * 64 * DM + ch; float* CR = (float*)(ws + WS_CARRY) + (size_t)b * 64 * DM + ch;
                float hc = 0.f;
                for (int i = 0; i < 64; ++i) { CR[(size_t)i * DM] = hc; const float2 ag = AG[(size_t)i * DM]; hc = ag.x * hc + ag.y; } }
        }
    }
    SEAM(3);
    if (IN(4)) {
        if (wv >= 4) __builtin_amdgcn_s_setprio(1);
#if (PROBE_MASK >> 4) & 1
        for (int it = bx; it < 4096; it += G) { const int qb = 127 - (it >> 5), bg = it & 31; attn_unit<DRYV>(wv, args, lds, bg >> 2, bg & 3, qb, DRYMODE); }
#endif
        {
            const unsigned myx = xb_xcc_id() & 7u;
            for (unsigned dx = 0; dx < 8; ++dx) {
                const unsigned qx = (myx + dx) & 7u;
                unsigned* qctr = (unsigned*)(ws + WS_CTR) + 256 + 16 * qx;
                for (;;) {
                    const int it = next_item(wv, lds, qctr); if (it >= 512) break;
                    const int qb = 127 - (it >> 2), g = it & 3, b = (int)((qx + (unsigned)g) & 7u);
                    attn_unit<0>(wv, args, lds, b, g, qb, 0);
                }
            }
        }
        __builtin_amdgcn_s_setprio(0);
        __syncthreads();
    }
    SEAM(4);
    for (int rep = 0; rep < (((PROBE_MASK >> 5) & 1) ? 2 : 1); ++rep) if (IN(5)) {
        GemmD g{(const char*)dout, (const char*)(ws + WS_WOUT), DM, DM, DM, 128, 128, 0}; Sched S; S.init(256, 4, G, bx);
        EpiStore<0, 0> E{(bf16*)(ws + WS_RAW), DM, nullptr, MTOK, DM};
        gemm_phase<EpiStore<0, 0>, true>(wv, lds, g, S, E);
    }
    SEAM(5);
    for (int rep = 0; rep < (((PROBE_MASK >> 6) & 1) ? 2 : 1); ++rep) if (IN(6)) {
        row_phase<true>(wv, (const bf16*)(ws + WS_RAW), args.in[0], (bf16*)args.out, (bf16*)(ws + WS_H2), args.in[3], args.in[19], G);
        const float* p = args.in[1]; bf16* pb = (bf16*)(ws + WS_PB);
        for (size_t i = ((size_t)bx * NTHR + TIDX) * 8; i < (size_t)MTOK * DPLE; i += (size_t)G * NTHR * 8) {
            const f32x4 a = *(const f32x4*)(p + i), b2 = *(const f32x4*)(p + i + 4);
            *(u32x4*)(pb + i) = (u32x4){pk2(a[0], a[1]), pk2(a[2], a[3]), pk2(b2[0], b2[1]), pk2(b2[2], b2[3])};
        }
    }
    SEAM(6);
    for (int rep = 0; rep < (((PROBE_MASK >> 7) & 1) ? 2 : 1); ++rep) if (IN(7)) {
        { GemmD g{(const char*)(ws + WS_H2), (const char*)(ws + WS_WGU), DM, DM, DM, 128, 128, 0}; Sched S; S.init(256, 22, G, bx); EpiSwi E{(bf16*)(ws + WS_ACT)};
          gemm_phase<EpiSwi, true>(wv, lds, g, S, E); }
        { GemmD g{(const char*)(ws + WS_PB), (const char*)(ws + WS_WPP), DPLE, DPLE, DPLE, 128, 128, 0}; Sched S; S.init(256, 4, G, bx);
          EpiStore<0, 0> E{(bf16*)(ws + WS_PP), DM, nullptr, MTOK, DM};
          gemm_phase<EpiStore<0, 0>, true>(wv, lds, g, S, E); }
    }
    SEAM(7);
    for (int rep = 0; rep < (((PROBE_MASK >> 8) & 1) ? 2 : 1); ++rep) if (IN(8)) {
        GemmD g{(const char*)(ws + WS_ACT), (const char*)(ws + WS_WDN), DFF, DFF, DFF, 128, 128, 0}; Sched S; S.init(256, 4, G, bx);
        EpiStore<0, 0> E{(bf16*)(ws + WS_RAW), DM, nullptr, MTOK, DM};
        gemm_phase<EpiStore<0, 0>, true>(wv, lds, g, S, E);
    }
    SEAM(8);
    if (IN(9)) {
        row_phase<false>(wv, (const bf16*)(ws + WS_RAW), nullptr, (bf16*)args.out, (bf16*)(ws + WS_H2), args.in[20], nullptr, G);
    }
    SEAM(9);
    if (IN(10)) {
        GemmD g{(const char*)(ws + WS_H2), (const char*)(ws + WS_WPG), DM, DM, DM, 128, 128, 0}; Sched S; S.init(256, 4, G, bx);
        EpiPle E{args.out, (const bf16*)(ws + WS_H2), (const bf16*)(ws + WS_PP), args.in[25]};
        gemm_phase<EpiPle, true>(wv, lds, g, S, E);
    }
#undef IN
#undef SEAM
}

constexpr int NPHASE = 11;
#ifndef ONE_LAUNCH
#define ONE_LAUNCH 1
#endif

extern "C" void kernel_launch(void* const* d_in, const int* in_sizes, int n_in, void* d_out, int out_size, void* d_ws, size_t ws_size, hipStream_t stream) {
    static int grid = 0;
    if (grid == 0) {
        if (n_in != 26 || out_size != MTOK * DM || ws_size < WS_END) { fprintf(stderr, "kernel_launch: unexpected problem shape (n_in %d out %d ws %zu)\n", n_in, out_size, ws_size); grid = -1; return; }
        int dev = 0, cus = 0, per_cu = 0;
        hipGetDevice(&dev); hipDeviceGetAttribute(&cus, hipDeviceAttributeMultiprocessorCount, dev);
        hipFuncSetAttribute((const void*)hybrid_fwd, hipFuncAttributeMaxDynamicSharedMemorySize, LDS_BYTES);
        if (hipOccupancyMaxActiveBlocksPerMultiprocessor(&per_cu, (const void*)hybrid_fwd, NTHR, LDS_BYTES) != hipSuccess || per_cu < 1) per_cu = 1;
        (void)hipGetLastError();
        grid = cus * 1;
    }
    if (grid <= 0) return;
    Args a{};
    for (int i = 0; i < 26; ++i) a.in[i] = (const float*)d_in[i];
    a.out = (float*)d_out; a.ws = (unsigned char*)d_ws;
    (void)hipMemsetAsync((unsigned char*)d_ws + WS_CTR, 0, CTL_BYTES, stream);
#if ONE_LAUNCH
    a.ph_lo = 0; a.ph_hi = NPHASE;
    void* kargs[] = {&a};
    hipError_t e = hipLaunchCooperativeKernel((const void*)hybrid_fwd, dim3(grid), dim3(NTHR), kargs, LDS_BYTES, stream);
    if (e != hipSuccess) fprintf(stderr, "cooperative launch failed: %s (grid %d)\n", hipGetErrorString(e), grid);
#else
    for (int ph = 0; ph < NPHASE; ++ph) { a.ph_lo = ph; a.ph_hi = ph + 1; hipLaunchKernelGGL(hybrid_fwd, dim3(grid), dim3(NTHR), LDS_BYTES, stream, a); }
#endif
}
```
